# Optimizing an MI355X kernel written in HIP

```python
import math
import jax, jax.numpy as jnp
from jax import lax
import numpy as np

D_MODEL = 1024
BATCH = 8
SEQ = 4096
DEPTH = 1

CHUNK = 64
QBLK = 128
MIX_WIDTH = D_MODEL
DIFF_QK_DIM = 64
DIFF_V_DIM = 2 * DIFF_QK_DIM
DIFF_HEADS = (MIX_WIDTH // 2) // DIFF_V_DIM
SB_DIM = 64
SB_HEADS = (MIX_WIDTH // 2) // SB_DIM
NUM_BUCKETS = 32
MAX_DISTANCE = 128
D_FF = ((8 * D_MODEL + 3 * 256 - 1) // (3 * 256)) * 256
EPS = 1e-6

DIFF_Q_COLS = DIFF_HEADS * 2 * DIFF_QK_DIM
DIFF_V_COLS = DIFF_HEADS * DIFF_V_DIM
SB_COLS = SB_HEADS * SB_DIM
IN_COLS = 2 * DIFF_Q_COLS + DIFF_V_COLS + 3 * SB_COLS
SPLIT_POINTS = (DIFF_Q_COLS, 2 * DIFF_Q_COLS, 2 * DIFF_Q_COLS + DIFF_V_COLS,
                2 * DIFF_Q_COLS + DIFF_V_COLS + SB_COLS,
                2 * DIFF_Q_COLS + DIFF_V_COLS + 2 * SB_COLS)

kernel_name = "hymba_diffattn_stickbreaking_block"


def rms_norm(x, w):
    xf = x.astype(jnp.float32)
    y = xf * lax.rsqrt(jnp.mean(xf * xf, axis=-1, keepdims=True) + EPS)
    return (y * w.astype(jnp.float32)).astype(x.dtype)


def t5_bucket(rel):
    nb = NUM_BUCKETS // 2
    max_exact = nb // 2
    ret = (rel > 0).astype(jnp.int32) * nb
    n = jnp.abs(rel)
    nf = jnp.maximum(n, 1).astype(jnp.float32)
    large = max_exact + (jnp.log(nf / max_exact) / math.log(MAX_DISTANCE / max_exact)
                         * (nb - max_exact)).astype(jnp.int32)
    large = jnp.minimum(large, nb - 1)
    return ret + jnp.where(n < max_exact, n, large)


def to_blocks(t):
    b, s = t.shape[0], t.shape[1]
    return jnp.moveaxis(t.reshape((b, s // QBLK, QBLK) + t.shape[2:]), 1, 0)


def from_blocks(t):
    t = jnp.moveaxis(t, 0, 1)
    return t.reshape((t.shape[0], t.shape[1] * t.shape[2]) + t.shape[3:])


def diff_attention(q, k, v, lam, rel_bias):
    s = q.shape[1]
    scale = DIFF_QK_DIM ** -0.5
    k_pos = jnp.arange(s, dtype=jnp.int32)
    k_chunk = k_pos // CHUNK

    def one_block(args):
        qb, blk = args
        q_pos = blk * QBLK + jnp.arange(QBLK, dtype=jnp.int32)
        logits = jnp.einsum('bqhcd,bkhcd->bhcqk', qb, k).astype(jnp.float32) * scale
        bias = rel_bias.astype(jnp.float32)[t5_bucket(k_pos[None, :] - q_pos[:, None])]
        logits = logits + jnp.transpose(bias, (2, 0, 1))[None, :, None]
        mask = k_chunk[None, :] <= (q_pos // CHUNK)[:, None]
        logits = jnp.where(mask[None, None, None], logits, -jnp.inf)
        p = jax.nn.softmax(logits, axis=-1)
        attn = p[:, :, 0] - lam * p[:, :, 1]
        return jnp.einsum('bhqk,bkhd->bqhd', attn.astype(v.dtype), v)

    nblk = s // QBLK
    out = lax.map(one_block, (to_blocks(q), jnp.arange(nblk, dtype=jnp.int32)))
    return from_blocks(out)


def stick_breaking_attention(q, k, v):
    s = q.shape[1]
    scale = SB_DIM ** -0.5
    k_pos = jnp.arange(s, dtype=jnp.int32)

    def one_block(args):
        qb, blk = args
        q_pos = blk * QBLK + jnp.arange(QBLK, dtype=jnp.int32)
        z = jnp.einsum('bqhd,bkhd->bhqk', qb, k).astype(jnp.float32) * scale
        mask = (k_pos[None, :] < q_pos[:, None])[None, None]
        log_1mb = jnp.where(mask, jax.nn.log_sigmoid(-z), 0.0)
        rem = lax.cumsum(log_1mb, axis=3, reverse=True) - log_1mb
        a = jnp.where(mask, jnp.exp(jax.nn.log_sigmoid(z) + rem), 0.0)
        return jnp.einsum('bhqk,bkhd->bqhd', a.astype(v.dtype), v)

    nblk = s // QBLK
    out = lax.map(one_block, (to_blocks(q), jnp.arange(nblk, dtype=jnp.int32)))
    return from_blocks(out)


def setup_inputs(seed: int = 0) -> dict:
    key = jax.random.key(seed)
    ks = jax.random.split(key, 20)
    f32 = jnp.float32

    def gain(k, shape):
        return 1.0 + 0.05 * jax.random.normal(k, shape, f32)

    return {
        "x": jax.random.normal(ks[0], (BATCH, SEQ, D_MODEL), f32),
        "norm1_w": gain(ks[1], (DEPTH, D_MODEL)),
        "w_in": jax.random.normal(ks[2], (DEPTH, D_MODEL, IN_COLS), f32) * D_MODEL ** -0.5,
        "q_norm_w": gain(ks[3], (DEPTH, DIFF_QK_DIM)),
        "k_norm_w": gain(ks[4], (DEPTH, DIFF_QK_DIM)),
        "lambda_q1": 0.1 * jax.random.normal(ks[5], (DEPTH, DIFF_QK_DIM), f32),
        "lambda_k1": 0.1 * jax.random.normal(ks[6], (DEPTH, DIFF_QK_DIM), f32),
        "lambda_q2": 0.1 * jax.random.normal(ks[7], (DEPTH, DIFF_QK_DIM), f32),
        "lambda_k2": 0.1 * jax.random.normal(ks[8], (DEPTH, DIFF_QK_DIM), f32),
        "diff_out_norm_w": gain(ks[9], (DEPTH, DIFF_V_DIM)),
        "sb_out_norm_w": gain(ks[10], (DEPTH, SB_DIM)),
        "w_out": jax.random.normal(ks[11], (DEPTH, MIX_WIDTH, D_MODEL), f32) * MIX_WIDTH ** -0.5,
        "norm2_w": gain(ks[12], (DEPTH, D_MODEL)),
        "w_gate": jax.random.normal(ks[13], (DEPTH, D_MODEL, D_FF), f32) * D_MODEL ** -0.5,
        "w_up": jax.random.normal(ks[14], (DEPTH, D_MODEL, D_FF), f32) * D_MODEL ** -0.5,
        "w_down": jax.random.normal(ks[15], (DEPTH, D_FF, D_MODEL), f32) * D_FF ** -0.5,
        "rel_bias": 0.5 * jax.random.normal(ks[16], (NUM_BUCKETS, DIFF_HEADS), f32),
    }


def reference(x, norm1_w, w_in, q_norm_w, k_norm_w, lambda_q1, lambda_k1, lambda_q2,
              lambda_k2, diff_out_norm_w, sb_out_norm_w, w_out, norm2_w, w_gate, w_up,
              w_down, rel_bias):
    b, s, _ = x.shape
    h = x
    for l in range(DEPTH):
        lambda_init = 0.8 - 0.6 * math.exp(-0.3 * l)
        u = rms_norm(h, norm1_w[l])
        proj = jnp.einsum('bsd,de->bse', u, w_in[l])
        dq, dk, dv, sq, sk, sv = jnp.split(proj, SPLIT_POINTS, axis=-1)

        dq = rms_norm(dq.reshape(b, s, DIFF_HEADS, 2, DIFF_QK_DIM), q_norm_w[l])
        dk = rms_norm(dk.reshape(b, s, DIFF_HEADS, 2, DIFF_QK_DIM), k_norm_w[l])
        dv = dv.reshape(b, s, DIFF_HEADS, DIFF_V_DIM)
        lam = (jnp.exp(jnp.sum(lambda_q1[l].astype(jnp.float32) * lambda_k1[l].astype(jnp.float32)))
               - jnp.exp(jnp.sum(lambda_q2[l].astype(jnp.float32) * lambda_k2[l].astype(jnp.float32)))
               + lambda_init)
        y_diff = diff_attention(dq, dk, dv, lam, rel_bias)
        y_diff = rms_norm(y_diff, diff_out_norm_w[l]) * (1.0 - lambda_init)

        sq = sq.reshape(b, s, SB_HEADS, SB_DIM)
        sk = sk.reshape(b, s, SB_HEADS, SB_DIM)
        sv = sv.reshape(b, s, SB_HEADS, SB_DIM)
        y_sb = rms_norm(stick_breaking_attention(sq, sk, sv), sb_out_norm_w[l])

        mix = jnp.concatenate([y_diff.reshape(b, s, DIFF_HEADS * DIFF_V_DIM),
                               y_sb.reshape(b, s, SB_HEADS * SB_DIM)], axis=-1)
        h = h + jnp.einsum('bse,ed->bsd', mix, w_out[l])

        u2 = rms_norm(h, norm2_w[l])
        gate = jnp.einsum('bsd,df->bsf', u2, w_gate[l])
        up = jnp.einsum('bsd,df->bsf', u2, w_up[l])
        h = h + jnp.einsum('bsf,fd->bsd', jax.nn.silu(gate) * up, w_down[l])
    return h
```

```cpp
#include <hip/hip_runtime.h>
#include <hip/hip_bf16.h>
#include <cstdint>
#include <cmath>

namespace {
constexpr int BATCH = 8, SEQ = 4096, DM = 1024, MTOK = BATCH * SEQ, INC = 3072, DFF = 2816;
constexpr float EPS = 1e-6f;
typedef unsigned short bf16_t;
__device__ __forceinline__ float bf2f(bf16_t v) { return __uint_as_float(((unsigned)v) << 16); }
__device__ __forceinline__ bf16_t f2bf(float f) { unsigned u = __float_as_uint(f); return (bf16_t)((u + 0x7fffu + ((u >> 16) & 1u)) >> 16); }

__device__ __forceinline__ int t5_bucket(int rel) {
    const int n = rel < 0 ? -rel : rel;
    int b;
    if (n < 8) b = n; else if (n < 12) b = 8; else if (n < 16) b = 9; else if (n < 23) b = 10; else if (n < 32) b = 11;
    else if (n < 46) b = 12; else if (n < 64) b = 13; else if (n < 91) b = 14; else b = 15;
    return b + (rel > 0 ? 16 : 0);
}

__global__ __launch_bounds__(256) void rmsnorm_rows(const float* __restrict__ x, const float* __restrict__ w, float* __restrict__ out) {
    const int row = blockIdx.x * 4 + (threadIdx.x >> 6), lane = threadIdx.x & 63;
    const float4* xr = (const float4*)(x + (size_t)row * DM);
    float4 v[4]; float s = 0.f;
#pragma unroll
    for (int j = 0; j < 4; ++j) { v[j] = xr[lane + 64 * j]; s += v[j].x * v[j].x + v[j].y * v[j].y + v[j].z * v[j].z + v[j].w * v[j].w; }
#pragma unroll
    for (int o = 1; o < 64; o <<= 1) s += __shfl_xor(s, o);
    const float r = 1.0f / sqrtf(s * (1.0f / DM) + EPS);
    float4* orow = (float4*)(out + (size_t)row * DM);
#pragma unroll
    for (int j = 0; j < 4; ++j) { const float4 ww = ((const float4*)w)[lane + 64 * j]; float4 o; o.x = v[j].x * r * ww.x; o.y = v[j].y * r * ww.y; o.z = v[j].z * r * ww.z; o.w = v[j].w * r * ww.w; orow[lane + 64 * j] = o; }
}

struct GemmArgs { const float* A; const float* W; const float* W2; int K, N; const float* resid; float* outf; bf16_t* outb; const float* qnw; const float* knw; };
template <int EPI> __global__ __launch_bounds__(256) void gemm_naive(GemmArgs g) {
    __shared__ float As[16][64 + 4];
    __shared__ float Bs[16][64 + 4];
    __shared__ float B2s[EPI == 2 ? 16 : 1][64 + 4];
    __shared__ float red[64][17];
    const int t = threadIdx.x, tx = t & 15, ty = t >> 4;
    const int row0 = blockIdx.y * 64, col0 = blockIdx.x * 64;
    float acc[4][4] = {}, acc2[4][4] = {};
    for (int k0 = 0; k0 < g.K; k0 += 16) {
        { const int r = t >> 2, kk = (t & 3) * 4; const float4 a = *(const float4*)(g.A + (size_t)(row0 + r) * g.K + k0 + kk);
          As[kk + 0][r] = a.x; As[kk + 1][r] = a.y; As[kk + 2][r] = a.z; As[kk + 3][r] = a.w; }
        { const int kk = t >> 4, c = (t & 15) * 4; const float4 b = *(const float4*)(g.W + (size_t)(k0 + kk) * g.N + col0 + c);
          Bs[kk][c] = b.x; Bs[kk][c + 1] = b.y; Bs[kk][c + 2] = b.z; Bs[kk][c + 3] = b.w;
          if (EPI == 2) { const float4 b2 = *(const float4*)(g.W2 + (size_t)(k0 + kk) * g.N + col0 + c); B2s[kk][c] = b2.x; B2s[kk][c + 1] = b2.y; B2s[kk][c + 2] = b2.z; B2s[kk][c + 3] = b2.w; } }
        __syncthreads();
#pragma unroll
        for (int kk = 0; kk < 16; ++kk) {
            float a[4], b[4], b2[4];
#pragma unroll
            for (int i = 0; i < 4; ++i) { a[i] = As[kk][ty * 4 + i]; b[i] = Bs[kk][tx * 4 + i]; if (EPI == 2) b2[i] = B2s[kk][tx * 4 + i]; }
#pragma unroll
            for (int i = 0; i < 4; ++i)
#pragma unroll
                for (int j = 0; j < 4; ++j) { acc[i][j] += a[i] * b[j]; if (EPI == 2) acc2[i][j] += a[i] * b2[j]; }
        }
        __syncthreads();
    }
    if (EPI == 0) {
        const int region = col0 / 512, cin = col0 % 512;
        bf16_t* outp = g.outb + (size_t)region * MTOK * 512;
        float rs[4] = {1.f, 1.f, 1.f, 1.f};
        if (region < 2) {
#pragma unroll
            for (int i = 0; i < 4; ++i) { float s = 0.f;
#pragma unroll
                for (int j = 0; j < 4; ++j) s += acc[i][j] * acc[i][j];
                red[ty * 4 + i][tx] = s; }
            __syncthreads();
#pragma unroll
            for (int i = 0; i < 4; ++i) { float s = 0.f; for (int j = 0; j < 16; ++j) s += red[ty * 4 + i][j]; rs[i] = 1.0f / sqrtf(s * (1.0f / 64.0f) + EPS); }
        }
        const float* nw = region == 0 ? g.qnw : g.knw;
#pragma unroll
        for (int i = 0; i < 4; ++i)
#pragma unroll
            for (int j = 0; j < 4; ++j) { float v = acc[i][j]; if (region < 2) v = v * rs[i] * nw[tx * 4 + j];
                outp[(size_t)(row0 + ty * 4 + i) * 512 + cin + tx * 4 + j] = f2bf(v); }
    } else if (EPI == 1) {
#pragma unroll
        for (int i = 0; i < 4; ++i) { const size_t o = (size_t)(row0 + ty * 4 + i) * g.N + col0 + tx * 4;
#pragma unroll
            for (int j = 0; j < 4; ++j) g.outf[o + j] = g.resid[o + j] + acc[i][j]; }
    } else {
#pragma unroll
        for (int i = 0; i < 4; ++i) { const size_t o = (size_t)(row0 + ty * 4 + i) * g.N + col0 + tx * 4;
#pragma unroll
            for (int j = 0; j < 4; ++j) { const float gt = acc[i][j]; g.outf[o + j] = gt / (1.0f + __expf(-gt)) * acc2[i][j]; } }
    }
}

__global__ __launch_bounds__(256) void diff_attn_naive(const bf16_t* __restrict__ dq, const bf16_t* __restrict__ dk, const bf16_t* __restrict__ dv, const float* __restrict__ rel_bias,
                                                       const float* lq1, const float* lk1, const float* lq2, const float* lk2, const float* __restrict__ onw, float* __restrict__ mix) {
    __shared__ float Ks[64][128];
    __shared__ float Vs[64][128];
    const int qc = blockIdx.x, h = blockIdx.y, b = blockIdx.z, t = threadIdx.x, row = t & 63, c = (t >> 6) & 1, dh = t >> 7;
    const int qpos = qc * 64 + row; const size_t tok0 = (size_t)b * SEQ;
    float q[64];
    { const bf16_t* qp = dq + (tok0 + qpos) * 512 + h * 128 + c * 64;
#pragma unroll
      for (int d = 0; d < 64; ++d) q[d] = bf2f(qp[d]); }
    const int nt = qc + 1;
    float m = -INFINITY, l = 0.f;
    for (int kt = 0; kt < nt; ++kt) {
        __syncthreads();
        for (int e = t; e < 64 * 128; e += 256) { const int j = e >> 7, d = e & 127; Ks[j][d] = bf2f(dk[(tok0 + kt * 64 + j) * 512 + h * 128 + d]); }
        __syncthreads();
        for (int j = 0; j < 64; ++j) { float s = 0.f;
#pragma unroll
            for (int d = 0; d < 64; ++d) s += q[d] * Ks[j][c * 64 + d];
            s = s * 0.125f + rel_bias[t5_bucket(kt * 64 + j - qpos) * 4 + h];
            const float mn = fmaxf(m, s); l = l * __expf(m - mn) + __expf(s - mn); m = mn; }
    }
    const float il = 1.0f / l;
    float acc[64];
#pragma unroll
    for (int d = 0; d < 64; ++d) acc[d] = 0.f;
    for (int kt = 0; kt < nt; ++kt) {
        __syncthreads();
        for (int e = t; e < 64 * 128; e += 256) { const int j = e >> 7, d = e & 127; Ks[j][d] = bf2f(dk[(tok0 + kt * 64 + j) * 512 + h * 128 + d]); Vs[j][d] = bf2f(dv[(tok0 + kt * 64 + j) * 512 + h * 128 + d]); }
        __syncthreads();
        for (int j = 0; j < 64; ++j) { float s = 0.f;
#pragma unroll
            for (int d = 0; d < 64; ++d) s += q[d] * Ks[j][c * 64 + d];
            s = s * 0.125f + rel_bias[t5_bucket(kt * 64 + j - qpos) * 4 + h];
            const float p = __expf(s - m) * il;
#pragma unroll
            for (int d = 0; d < 64; ++d) acc[d] += p * Vs[j][dh * 64 + d]; }
    }
    float s1 = 0.f, s2 = 0.f;
    for (int d = 0; d < 64; ++d) { s1 += lq1[d] * lk1[d]; s2 += lq2[d] * lk2[d]; }
    const float lam = __expf(s1) - __expf(s2) + 0.2f;
    __syncthreads();
    if (c == 1) {
#pragma unroll
        for (int d = 0; d < 64; ++d) Ks[row][dh * 64 + d] = acc[d]; }
    __syncthreads();
    if (c == 0) { float ss = 0.f;
#pragma unroll
        for (int d = 0; d < 64; ++d) { acc[d] -= lam * Ks[row][dh * 64 + d]; ss += acc[d] * acc[d]; }
        Vs[row][dh] = ss; }
    __syncthreads();
    if (c == 0) { const float r = 1.0f / sqrtf((Vs[row][0] + Vs[row][1]) * (1.0f / 128.0f) + EPS);
        float* op = mix + (tok0 + qpos) * DM + h * 128 + dh * 64;
#pragma unroll
        for (int d = 0; d < 64; ++d) op[d] = acc[d] * r * onw[dh * 64 + d] * 0.8f; }
}

__global__ __launch_bounds__(64) void sb_attn_naive(const bf16_t* __restrict__ sq, const bf16_t* __restrict__ sk, const bf16_t* __restrict__ sv, const float* __restrict__ onw, float* __restrict__ mix) {
    __shared__ float Ks[64][64];
    __shared__ float Vs[64][64];
    const int qc = blockIdx.x, h = blockIdx.y, b = blockIdx.z, t = threadIdx.x;
    const int qpos = qc * 64 + t; const size_t tok0 = (size_t)b * SEQ;
    float q[64], acc[64];
    { const bf16_t* qp = sq + (tok0 + qpos) * 512 + h * 64;
#pragma unroll
      for (int d = 0; d < 64; ++d) { q[d] = bf2f(qp[d]); acc[d] = 0.f; } }
    float rem = 0.f;
    for (int kt = qc; kt >= 0; --kt) {
        __syncthreads();
        for (int e = t; e < 64 * 64; e += 64) { const int j = e >> 6, d = e & 63; Ks[j][d] = bf2f(sk[(tok0 + kt * 64 + j) * 512 + h * 64 + d]); Vs[j][d] = bf2f(sv[(tok0 + kt * 64 + j) * 512 + h * 64 + d]); }
        __syncthreads();
        for (int j = 63; j >= 0; --j) {
            if (kt * 64 + j < qpos) { float z = 0.f;
#pragma unroll
                for (int d = 0; d < 64; ++d) z += q[d] * Ks[j][d];
                z *= 0.125f;
                const float sp = fmaxf(z, 0.f) + log1pf(__expf(-fabsf(z)));
                const float a = __expf(z - sp + rem);
#pragma unroll
                for (int d = 0; d < 64; ++d) acc[d] += a * Vs[j][d];
                rem -= sp; }
        }
    }
    float ss = 0.f;
#pragma unroll
    for (int d = 0; d < 64; ++d) ss += acc[d] * acc[d];
    const float r = 1.0f / sqrtf(ss * (1.0f / 64.0f) + EPS);
    float* op = mix + (tok0 + qpos) * DM + 512 + h * 64;
#pragma unroll
    for (int d = 0; d < 64; ++d) op[d] = acc[d] * r * onw[d];
}
}

extern "C" void kernel_launch(void* const* d_in, const int* in_sizes, int n_in, void* d_out, int out_size, void* d_ws, size_t ws_size, hipStream_t stream) {
    const float* x = (const float*)d_in[0]; const float* n1w = (const float*)d_in[1]; const float* w_in = (const float*)d_in[2];
    const float* qnw = (const float*)d_in[3]; const float* knw = (const float*)d_in[4];
    const float* lq1 = (const float*)d_in[5]; const float* lk1 = (const float*)d_in[6]; const float* lq2 = (const float*)d_in[7]; const float* lk2 = (const float*)d_in[8];
    const float* donw = (const float*)d_in[9]; const float* sonw = (const float*)d_in[10]; const float* w_out = (const float*)d_in[11]; const float* n2w = (const float*)d_in[12];
    const float* w_gate = (const float*)d_in[13]; const float* w_up = (const float*)d_in[14]; const float* w_down = (const float*)d_in[15]; const float* rel_bias = (const float*)d_in[16];
    float* out = (float*)d_out; unsigned char* ws = (unsigned char*)d_ws;
    constexpr size_t MiB = 1u << 20;
    bf16_t* proj = (bf16_t*)(ws);
    float* xn = (float*)(ws + 192 * MiB);
    float* mix = xn;
    float* u2 = (float*)(ws + 384 * MiB);
    float* act = (float*)(ws);
    rmsnorm_rows<<<MTOK / 4, 256, 0, stream>>>(x, n1w, xn);
    { GemmArgs g{xn, w_in, nullptr, DM, INC, nullptr, nullptr, proj, qnw, knw}; gemm_naive<0><<<dim3(INC / 64, MTOK / 64), 256, 0, stream>>>(g); }
    const bf16_t* dq = proj; const bf16_t* dk = proj + (size_t)MTOK * 512; const bf16_t* dv = proj + (size_t)2 * MTOK * 512;
    const bf16_t* sq = proj + (size_t)3 * MTOK * 512; const bf16_t* sk = proj + (size_t)4 * MTOK * 512; const bf16_t* sv = proj + (size_t)5 * MTOK * 512;
    diff_attn_naive<<<dim3(SEQ / 64, 4, BATCH), 256, 0, stream>>>(dq, dk, dv, rel_bias, lq1, lk1, lq2, lk2, donw, mix);
    sb_attn_naive<<<dim3(SEQ / 64, 8, BATCH), 64, 0, stream>>>(sq, sk, sv, sonw, mix);
    { GemmArgs g{mix, w_out, nullptr, DM, DM, x, out, nullptr, nullptr, nullptr}; gemm_naive<1><<<dim3(DM / 64, MTOK / 64), 256, 0, stream>>>(g); }
    rmsnorm_rows<<<MTOK / 4, 256, 0, stream>>>(out, n2w, u2);
    { GemmArgs g{u2, w_gate, w_up, DM, DFF, nullptr, act, nullptr, nullptr, nullptr}; gemm_naive<2><<<dim3(DFF / 64, MTOK / 64), 256, 0, stream>>>(g); }
    { GemmArgs g{act, w_down, nullptr, DFF, DM, out, out, nullptr, nullptr, nullptr}; gemm_naive<1><<<dim3(DM / 64, MTOK / 64), 256, 0, stream>>>(g); }
}
```

```cpp
#ifndef MK_REP_P0
#define MK_REP_P0 1
#endif
#ifndef MK_REP_P1
#define MK_REP_P1 1
#endif
#ifndef MK_REP_DIFF
#define MK_REP_DIFF 1
#endif
#ifndef MK_REP_SB
#define MK_REP_SB 1
#endif
#ifndef MK_REP_P3
#define MK_REP_P3 1
#endif
#ifndef MK_REP_P4
#define MK_REP_P4 1
#endif
#ifndef MK_REP_P5
#define MK_REP_P5 1
#endif
#ifndef MK_DIFF_PRIO_STATIC
#define MK_DIFF_PRIO_STATIC 1
#endif
#ifndef MK_DIFF_PRIO_B
#define MK_DIFF_PRIO_B 0
#endif
#ifndef MK_PROBE_BAR2
#define MK_PROBE_BAR2 0
#endif
#ifndef MK_PROBE_DMA2
#define MK_PROBE_DMA2 0
#endif
#ifndef MK_PROBE_XBAR2
#define MK_PROBE_XBAR2 0
#endif
#ifndef MK_WGM_P5
#define MK_WGM_P5 8
#endif
#ifndef MK_PROBE_SBVALU
#define MK_PROBE_SBVALU 0
#endif
#ifndef MK_PROBE_DFVALU
#define MK_PROBE_DFVALU 0
#endif
#ifndef MK_PROBE_SBX2
#define MK_PROBE_SBX2 0
#endif
#ifndef MK_PROBE_CLOCK
#define MK_PROBE_CLOCK 0
#endif
#ifndef MK_NT_P5
#define MK_NT_P5 0
#endif
#ifndef MK_REV_P5
#define MK_REV_P5 0
#endif
#ifndef MK_FAST_BOUND
#define MK_FAST_BOUND 60.f
#endif
#ifndef MK_PROBE_CLOCK4
#define MK_PROBE_CLOCK4 0
#endif
#ifndef MK_XTOUCH
#define MK_XTOUCH 0
#endif
#ifndef MK_PROBE_IDLE
#define MK_PROBE_IDLE 0
#endif
#include <hip/hip_runtime.h>
#include <cstdio>
#include <cstdint>
namespace pg8 {
#define PG8_LAS __attribute__((address_space(3)))
typedef unsigned short bf16_t;
typedef short bf16x8 __attribute__((ext_vector_type(8)));
typedef float f32x4 __attribute__((ext_vector_type(4)));
typedef unsigned u32x4 __attribute__((ext_vector_type(4)));
constexpr int BM = 256, BK = 64, HALF = 128, HTB = HALF * BK * 2  , STAGE_BYTES = 8 * HTB, NXCD = 8, WGM = 8;

__host__ __device__ __forceinline__ int lds_byte(int r, int c) { const int st = (r >> 4) * 2 + (c >> 5), rr = r & 15, cc = c & 31, ob = rr * 64 + cc * 2; return st * 1024 + (ob ^ (((ob >> 9) & 1) << 5)); }
__host__ __device__ __forceinline__ void stage_rc(int b, int& R, int& C) { const int st = b / 1024, sb = b % 1024, swz = sb ^ (((sb >> 9) & 1) << 5); R = (st >> 1) * 16 + swz / 64; C = (st & 1) * 32 + (swz % 64) / 2; }
__host__ __device__ __forceinline__ int perm32(int rho) { const int n = rho >> 4, i = rho & 15; return 8 * (i >> 2) + 4 * n + (i & 3); }

struct Unit { int pm, pn, rep; };
struct Gemm { const bf16_t* A; const bf16_t* Bt; int M, N, K; };

struct StaticOrder {
    int nM, nN, nwg, G, c, reps, wgm, rev;
    __host__ __device__ void init(int M, int N, int G_, int c_, int reps_ = 1, int wgm_ = WGM, int rev_ = 0) { nM = M / BM; nN = N / BM; nwg = nM * nN; G = G_; c = c_; reps = reps_; wgm = wgm_; rev = rev_; }
    __host__ __device__ bool next(int i, Unit& u) const {
        const long L = (long)i * G + c; if (L >= (long)nwg * reps) return false;
        int wgid = (int)(L % nwg); u.rep = (int)(L / nwg); { const int q = nwg / NXCD, r = nwg % NXCD, xcd = wgid % NXCD, off0 = wgid / NXCD, off = rev ? q + (xcd < r ? 1 : 0) - 1 - off0 : off0; wgid = (xcd < r ? xcd * (q + 1) : r * (q + 1) + (xcd - r) * q) + off; }
        const int nig = wgm * nN, gid = wgid / nig, fm = gid * wgm, gsz = (nM - fm) < wgm ? (nM - fm) : wgm;
        u.pm = fm + ((wgid % nig) % gsz); u.pn = (wgid % nig) / gsz; return true;
    }
    __device__ __forceinline__ void a_ready(const Unit&) const {}
    __device__ __forceinline__ void done(const Unit&) const {}
};

__device__ __forceinline__ unsigned cvt_pk_bf16(float lo, float hi) { unsigned r; asm volatile("v_cvt_pk_bf16_f32 %0, %1, %2" : "=v"(r) : "v"(lo), "v"(hi)); return r; }
typedef float f32x2 __attribute__((ext_vector_type(2)));
constexpr int MTOK_ = 32768;
constexpr float C2_ = 0.125f * 1.4426950408889634f;
constexpr float EPS_ = 1e-6f;
typedef unsigned u32x2 __attribute__((ext_vector_type(2)));
typedef float f32x2_t __attribute__((ext_vector_type(2)));
__device__ __forceinline__ float rows4_sum(float s) { auto a = __builtin_amdgcn_permlane16_swap(__float_as_uint(s), __float_as_uint(s), false, false); s = __uint_as_float(a[0]) + __uint_as_float(a[1]);
    auto c = __builtin_amdgcn_permlane32_swap(__float_as_uint(s), __float_as_uint(s), false, false); return __uint_as_float(c[0]) + __uint_as_float(c[1]); }
__host__ __device__ __forceinline__ int rinv_index(int r) { return ((((r >> 8) * 2 + ((r >> 6) & 1)) * 16 + (r & 15)) << 3) + ((r >> 7) & 1) * 4 + ((r >> 4) & 3); }
__device__ __forceinline__ void swap16(unsigned& a, unsigned& b) { auto r = __builtin_amdgcn_permlane16_swap(a, b, false, false); a = r[0]; b = r[1]; }
__device__ __forceinline__ int wide_coff(int fq) { return 4 * fq + ((fq & 1) ? 12 : 0); }
__device__ __forceinline__ void wide_load(const bf16_t* p, u32x2& v0, u32x2& v1) { const u32x4 L = *(const u32x4*)p; unsigned a = L.x, b = L.y, c = L.z, d = L.w; swap16(a, c); swap16(b, d); v0.x = a; v0.y = b; v1.x = c; v1.y = d; }
__device__ __forceinline__ void wide_store(bf16_t* p, u32x2 w0, u32x2 w1) { unsigned a = w0.x, b = w0.y, c = w1.x, d = w1.y; swap16(a, c); swap16(b, d); u32x4 S; S.x = a; S.y = b; S.z = c; S.w = d; *(u32x4*)p = S; }
__device__ __forceinline__ size_t tile_image_off(int region, int row, int col) {
    if (region == 0 || region == 3) return (size_t)row * 512 + col;
    const int b = row >> 12, t = (row >> 6) & 63, rr = row & 63;
    if (region == 1) { const int h = col >> 7, ch = col & 127; return ((size_t)((b * 4 + h) * 64 + t) << 13) + (ch >> 3) * 512 + rr * 8; }
    if (region == 2) { const int h = col >> 7, ch = col & 127; return ((size_t)((b * 4 + h) * 64 + t) << 13) + (ch >> 5) * 2048 + rr * 32 + (ch & 31); }
    if (region == 4) { const int h = col >> 6, ch = col & 63;  return ((size_t)((b * 8 + h) * 64 + t) << 12) + (ch >> 3) * 512 + rr * 8; }
    { const int h = col >> 6, ch = col & 63;                   return ((size_t)((b * 8 + h) * 64 + t) << 12) + (ch >> 5) * 2048 + rr * 32 + (ch & 31); }
}
struct EpiInProj {
    static constexpr bool PERM = true, AFTER_DRAIN = false, HOOK = false;
    bf16_t* proj; const float* qnw; const float* knw;
    __device__ __forceinline__ void operator()(const f32x4 (&acc)[2][2][4][2], const Unit& u, int wr, int wc, int fr, int fq) const {
        const int region = u.pn >> 1, cin0 = (u.pn & 1) * 256 + 64 * wc + 8 * fq;
        bf16_t* base = proj + (size_t)region * MTOK_ * 512;
        const int row0 = u.pm * BM + wr * 64 + fr;
        f32x4 wv[2][2]; float post = 1.f;
        const bool nrm = region < 2;
        { const float* nw = region == 0 ? qnw : knw;
#pragma unroll
          for (int bj = 0; bj < 2; ++bj)
#pragma unroll
            for (int n = 0; n < 2; ++n) wv[bj][n] = nrm ? *(const f32x4*)(nw + 32 * bj + 8 * fq + 4 * n) : (f32x4){1.f, 1.f, 1.f, 1.f}; }
        if (region == 0 || region == 3) post = C2_;
#pragma unroll
        for (int ai = 0; ai < 2; ++ai)
#pragma unroll
            for (int m = 0; m < 4; ++m) {
                float rs = post;
                if (nrm) { f32x2_t s2 = {0.f, 0.f};
#pragma unroll
                    for (int bj = 0; bj < 2; ++bj)
#pragma unroll
                        for (int n = 0; n < 2; ++n) { const f32x4 v = acc[ai][bj][m][n]; const f32x2_t lo = {v[0], v[1]}, hi = {v[2], v[3]}; s2 = lo * lo + s2; s2 = hi * hi + s2; }
                    const float s = rows4_sum(s2.x + s2.y);
                    rs = post * __builtin_amdgcn_rsqf(s * (1.0f / 64.0f) + EPS_); }
                const int row = row0 + ai * HALF + m * 16;
#pragma unroll
                for (int bj = 0; bj < 2; ++bj) { f32x4 v0 = acc[ai][bj][m][0], v1 = acc[ai][bj][m][1];
                    if (nrm) { v0 = v0 * wv[bj][0] * rs; v1 = v1 * wv[bj][1] * rs; } else if (region == 3) { v0 = v0 * C2_; v1 = v1 * C2_; }
                    u32x4 w; w.x = cvt_pk_bf16(v0[0], v0[1]); w.y = cvt_pk_bf16(v0[2], v0[3]); w.z = cvt_pk_bf16(v1[0], v1[1]); w.w = cvt_pk_bf16(v1[2], v1[3]);
                    *(u32x4*)(base + tile_image_off(region, row, cin0 + 32 * bj)) = w; }
            }
    }
};
struct EpiOutProj {
    static constexpr bool PERM = false, AFTER_DRAIN = false, HOOK = false;
    const bf16_t* xn; const float* rinv; bf16_t* xh; float* ssq;
    __device__ __forceinline__ void operator()(const f32x4 (&acc)[2][2][4][2], const Unit& u, int wr, int wc, int fr, int fq) const {
        const int row0 = u.pm * BM + wr * 64 + fr, colw = u.pn * BM + wc * 32 + wide_coff(fq);
        u32x2 xv[2][4][2][2]; float ri[2][4], ss[2][4];
        { const f32x4* rp = (const f32x4*)(rinv + rinv_index(u.pm * BM + wr * 64 + fr)); const f32x4 r0 = rp[0], r1 = rp[1];
          ri[0][0] = r0[0]; ri[0][1] = r0[1]; ri[0][2] = r0[2]; ri[0][3] = r0[3]; ri[1][0] = r1[0]; ri[1][1] = r1[1]; ri[1][2] = r1[2]; ri[1][3] = r1[3]; }
#pragma unroll
        for (int ai = 0; ai < 2; ++ai)
#pragma unroll
            for (int m = 0; m < 4; ++m) {
#pragma unroll
                for (int bj = 0; bj < 2; ++bj) wide_load(xn + (size_t)(row0 + ai * HALF + m * 16) * 1024 + colw + bj * HALF, xv[ai][m][bj][0], xv[ai][m][bj][1]); }
#pragma unroll
        for (int ai = 0; ai < 2; ++ai)
#pragma unroll
            for (int m = 0; m < 4; ++m) { const int row = row0 + ai * HALF + m * 16; const size_t off = (size_t)row * 1024 + colw; f32x2_t s2 = {0.f, 0.f}; const float rr = ri[ai][m];
#pragma unroll
                for (int bj = 0; bj < 2; ++bj) { u32x2 w[2];
#pragma unroll
                    for (int n = 0; n < 2; ++n) { const u32x2 hb = xv[ai][m][bj][n];
                        const f32x4 r = (f32x4){__uint_as_float(hb.x << 16), __uint_as_float(hb.x & 0xffff0000u), __uint_as_float(hb.y << 16), __uint_as_float(hb.y & 0xffff0000u)} * rr + acc[ai][bj][m][n];
                        { const f32x2_t lo = {r[0], r[1]}, hi = {r[2], r[3]}; s2 = lo * lo + s2; s2 = hi * hi + s2; }
                        w[n].x = cvt_pk_bf16(r[0], r[1]); w[n].y = cvt_pk_bf16(r[2], r[3]); }
                    wide_store(xh + off + bj * HALF, w[0], w[1]); }
                ss[ai][m] = rows4_sum(s2.x + s2.y); }
#pragma unroll
        for (int ai = 0; ai < 2; ++ai) { const float v = fq == 0 ? ss[ai][0] : fq == 1 ? ss[ai][1] : fq == 2 ? ss[ai][2] : ss[ai][3];
            ssq[(size_t)(row0 + ai * HALF + fq * 16) * 16 + u.pn * 4 + wc] = v; }
    }
};
struct EpiSwiGLU {
    static constexpr bool PERM = true, AFTER_DRAIN = false, HOOK = true;
    const float* ssq; bf16_t* act; const PG8_LAS float* rs_lds; int pml0, pml1, pml2, pml3;
    template <bool SQUARED> __device__ __forceinline__ void build_cache(int tid) const {
        PG8_LAS float* rsl = (PG8_LAS float*)rs_lds;
        for (int i = tid; i < 4 * 256; i += 512) { const int sl = i >> 8, pm = sl == 0 ? pml0 : sl == 1 ? pml1 : sl == 2 ? pml2 : pml3;
            if (pm >= 0) { const f32x4* pp = (const f32x4*)(ssq + (size_t)(pm * 256 + (i & 255)) * 16); const f32x4 a = pp[0], b2 = pp[1], c2 = pp[2], d2 = pp[3];
                const float s = ((a.x + a.y) + (a.z + a.w)) + ((b2.x + b2.y) + (b2.z + b2.w)) + ((c2.x + c2.y) + (c2.z + c2.w)) + ((d2.x + d2.y) + (d2.z + d2.w));
                const float v = s * (1.0f / 1024.0f) + EPS_; rsl[i] = SQUARED ? 1.0f / v : 1.0f / sqrtf(v); } }
        __syncthreads();
    }
    __device__ __forceinline__ void hook(int tid) const { build_cache<false>(tid); }
    __device__ __forceinline__ void operator()(const f32x4 (&acc)[2][2][4][2], const Unit& u, int wr, int wc, int fr, int fq) const {
        const int row0 = u.pm * BM + wr * 64 + fr, col0 = u.pn * HALF + wc * 32 + 8 * fq;
        const int slot = u.pm == pml0 ? 0 : u.pm == pml1 ? 1 : u.pm == pml2 ? 2 : u.pm == pml3 ? 3 : -1;
#pragma unroll
        for (int ai = 0; ai < 2; ++ai)
#pragma unroll
            for (int m = 0; m < 4; ++m) { const int row = row0 + ai * HALF + m * 16;
                float rstd;
                if (slot >= 0) rstd = rs_lds[slot * BM + wr * 64 + fr + ai * HALF + m * 16];
                else { const f32x4 p = *(const f32x4*)(ssq + (size_t)row * 16 + 4 * fq); float s = (p[0] + p[1]) + (p[2] + p[3]);
                    s += __shfl_xor(s, 16); s += __shfl_xor(s, 32);
                    rstd = 1.0f / sqrtf(s * (1.0f / 1024.0f) + EPS_); }
                float a[8]; const float kk = -1.4426950408889634f * rstd;
#pragma unroll
                for (int n = 0; n < 2; ++n)
#pragma unroll
                    for (int i = 0; i < 4; i += 2) {
                        const f32x2_t g = {acc[ai][0][m][n][i], acc[ai][0][m][n][i + 1]}, up = {acc[ai][1][m][n][i], acc[ai][1][m][n][i + 1]};
                        const f32x2_t z = g * kk; f32x2_t d = {__builtin_amdgcn_exp2f(z.x), __builtin_amdgcn_exp2f(z.y)}; d = d + 1.0f;
                        const f32x2_t r = {__builtin_amdgcn_rcpf(d.x), __builtin_amdgcn_rcpf(d.y)}, o2 = (g * up) * r;
                        a[4 * n + i] = o2.x; a[4 * n + i + 1] = o2.y; }
                u32x4 w; w.x = cvt_pk_bf16(a[0], a[1]); w.y = cvt_pk_bf16(a[2], a[3]); w.z = cvt_pk_bf16(a[4], a[5]); w.w = cvt_pk_bf16(a[6], a[7]);
                *(u32x4*)(act + (size_t)row * 2816 + col0) = w; }
    }
};
struct EpiDown {
    static constexpr bool PERM = false, AFTER_DRAIN = false, HOOK = true;
    const bf16_t* xh; float* out; const float* ssq; const PG8_LAS float* rs_lds; int pml0, pml1, pml2, pml3;
    template <bool SQUARED> __device__ __forceinline__ void build_cache(int tid) const {
        PG8_LAS float* rsl = (PG8_LAS float*)rs_lds;
        for (int i = tid; i < 4 * 256; i += 512) { const int sl = i >> 8, pm = sl == 0 ? pml0 : sl == 1 ? pml1 : sl == 2 ? pml2 : pml3;
            if (pm >= 0) { const f32x4* pp = (const f32x4*)(ssq + (size_t)(pm * 256 + (i & 255)) * 16); const f32x4 a = pp[0], b2 = pp[1], c2 = pp[2], d2 = pp[3];
                const float s = ((a.x + a.y) + (a.z + a.w)) + ((b2.x + b2.y) + (b2.z + b2.w)) + ((c2.x + c2.y) + (c2.z + c2.w)) + ((d2.x + d2.y) + (d2.z + d2.w));
                const float v = s * (1.0f / 1024.0f) + EPS_; rsl[i] = SQUARED ? 1.0f / v : 1.0f / sqrtf(v); } }
        __syncthreads();
    }
    __device__ __forceinline__ void hook(int tid) const { build_cache<true>(tid); }
    __device__ __forceinline__ void operator()(const f32x4 (&acc)[2][2][4][2], const Unit& u, int wr, int wc, int fr, int fq) const {
        const int row0 = u.pm * BM + wr * 64 + fr, col0 = u.pn * BM + wc * 32 + 4 * fq;
        u32x2 hv[2][4][2][2]; float rs2[2][4];
        const int slot = u.pm == pml0 ? 0 : u.pm == pml1 ? 1 : u.pm == pml2 ? 2 : u.pm == pml3 ? 3 : -1;
#pragma unroll
        for (int ai = 0; ai < 2; ++ai)
#pragma unroll
            for (int m = 0; m < 4; ++m)
#pragma unroll
                for (int bj = 0; bj < 2; ++bj) wide_load(xh + (size_t)(row0 + ai * HALF + m * 16) * 1024 + (col0 - 4 * fq + wide_coff(fq)) + bj * HALF, hv[ai][m][bj][0], hv[ai][m][bj][1]);
#pragma unroll
        for (int ai = 0; ai < 2; ++ai)
#pragma unroll
            for (int m = 0; m < 4; ++m) {
                if (slot >= 0) rs2[ai][m] = rs_lds[slot * BM + wr * 64 + fr + ai * HALF + m * 16];
                else { const f32x4 p = *(const f32x4*)(ssq + (size_t)(row0 + ai * HALF + m * 16) * 16 + 4 * fq); float s = (p[0] + p[1]) + (p[2] + p[3]);
                    s += __shfl_xor(s, 16); s += __shfl_xor(s, 32); rs2[ai][m] = 1.0f / (s * (1.0f / 1024.0f) + EPS_); } }
#pragma unroll
        for (int ai = 0; ai < 2; ++ai)
#pragma unroll
            for (int m = 0; m < 4; ++m) { const size_t off = (size_t)(row0 + ai * HALF + m * 16) * 1024 + col0; const float r2 = rs2[ai][m];
#pragma unroll
                for (int bj = 0; bj < 2; ++bj)
#pragma unroll
                    for (int n = 0; n < 2; ++n) { const size_t o = off + bj * HALF + n * 16; const u32x2 hb = hv[ai][m][bj][n];
                        const f32x4 h1 = (f32x4){__uint_as_float(hb.x << 16), __uint_as_float(hb.x & 0xffff0000u), __uint_as_float(hb.y << 16), __uint_as_float(hb.y & 0xffff0000u)};
                        *(f32x4*)(out + o) = h1 + acc[ai][bj][m][n] * r2; } }
    }
};

template <class Epi, class Sched, bool ALIGN_EPI = false, bool SP2 = false>
__device__ __forceinline__ void gemm_phase(PG8_LAS unsigned char* lds, const Gemm g, const Sched& S, const Epi& E) {
    const int tid = threadIdx.x, wid = __builtin_amdgcn_readfirstlane(tid >> 6), lane = tid & 63, wr = wid >> 2, wc = wid & 3, fr = lane & 15, fq = lane >> 4;
    const int K = g.K, nt = K / BK;
    unsigned voffA[2], voffB[2];
#pragma unroll
    for (int i = 0; i < 2; ++i) { int R, C; stage_rc(tid * 16 + i * 8192, R, C); const int Rb = Epi::PERM ? ((R & ~31) + perm32(R & 31)) : R;
        voffA[i] = (unsigned)(R * K + C) * 2u; voffB[i] = (unsigned)(Rb * K + C) * 2u; }
    const size_t kstep = (size_t)(BK * 2);
    const size_t hstep = (size_t)HALF * K * 2;
    const size_t tstep = 2 * hstep;
    const unsigned ldsw = (unsigned)wid * 1024u;
    const int aoff = lds_byte(wr * 64 + fr, fq * 8), boff = lds_byte(wc * 32 + fr, fq * 8);
#define PG8_SA(b, h) (((b) * 2 + (h)) * HTB)
#define PG8_SB(b, h) ((4 + (b) * 2 + (h)) * HTB)
#define PG8_STAGE(bufoff, gbase, voff) do { _Pragma("unroll") for (int _i = 0; _i < 2; ++_i) \
        __builtin_amdgcn_global_load_lds((const unsigned*)((const char*)(gbase) + (voff)[_i]), (PG8_LAS unsigned*)(lds + (bufoff) + ldsw + _i * 8192), 16, 0, 0); } while (0)
#define PG8_LDA(dst, b, h) do { _Pragma("unroll") for (int m = 0; m < 4; ++m) _Pragma("unroll") for (int k = 0; k < 2; ++k) dst[m][k] = *(const PG8_LAS bf16x8*)(lds + PG8_SA(b, h) + aoff + m * 2048 + k * 1024); } while (0)
#define PG8_LDB(dst, b, h) do { _Pragma("unroll") for (int n = 0; n < 2; ++n) _Pragma("unroll") for (int k = 0; k < 2; ++k) dst[n][k] = *(const PG8_LAS bf16x8*)(lds + PG8_SB(b, h) + boff + n * 2048 + k * 1024); } while (0)
#define PG8_MMA(ai, bj, At, Bt) do { __builtin_amdgcn_s_setprio(1); _Pragma("unroll") for (int m = 0; m < 4; ++m) _Pragma("unroll") for (int n = 0; n < 2; ++n) _Pragma("unroll") for (int k = 0; k < 2; ++k) \
        acc[ai][bj][m][n] = __builtin_amdgcn_mfma_f32_16x16x32_bf16(Bt[n][k], At[m][k], acc[ai][bj][m][n], 0, 0, 0); __builtin_amdgcn_s_setprio(0); } while (0)
#define PG8_WAIT_V(n) asm volatile("s_waitcnt vmcnt(" #n ")" ::: "memory")
#define PG8_WAIT_L(n) asm volatile("s_waitcnt lgkmcnt(" #n ")" ::: "memory")
#define PG8_BAR __builtin_amdgcn_s_barrier()
#define PG8_SCHED __builtin_amdgcn_sched_barrier(0)
    Unit cur, nxt; int ui = 0;
    if (!S.next(0, cur)) return;
    f32x4 acc[2][2][4][2];
#pragma unroll
    for (int a = 0; a < 2; ++a)
#pragma unroll
        for (int b = 0; b < 2; ++b)
#pragma unroll
            for (int m = 0; m < 4; ++m)
#pragma unroll
                for (int n = 0; n < 2; ++n) acc[a][b][m][n] = (f32x4){0.f, 0.f, 0.f, 0.f};
    bf16x8 At[4][2], B0[2][2], B1[2][2];
    const char* cA = (const char*)g.A + (size_t)cur.pm * tstep; const char* cB = (const char*)g.Bt + (size_t)cur.pn * tstep;
    S.a_ready(cur);
    if constexpr (SP2) {
        PG8_STAGE(PG8_SB(0, 0), cB, voffB); PG8_STAGE(PG8_SB(0, 1), cB + hstep, voffB); PG8_STAGE(PG8_SA(0, 0), cA, voffA); PG8_STAGE(PG8_SA(0, 1), cA + hstep, voffA);
        if constexpr (Epi::HOOK) E.hook(tid);
        if (wr == 1) PG8_BAR;
        PG8_WAIT_V(2); PG8_BAR;
        PG8_STAGE(PG8_SB(1, 0), cB + kstep, voffB); PG8_STAGE(PG8_SA(1, 0), cA + kstep, voffA); PG8_STAGE(PG8_SB(1, 1), cB + hstep + kstep, voffB);
        PG8_WAIT_V(6); PG8_BAR;
    } else {
        PG8_STAGE(PG8_SB(0, 0), cB, voffB); PG8_STAGE(PG8_SA(0, 0), cA, voffA); PG8_STAGE(PG8_SB(0, 1), cB + hstep, voffB); PG8_STAGE(PG8_SA(0, 1), cA + hstep, voffA);
        if (wr == 1) PG8_BAR;
        PG8_WAIT_V(4); PG8_BAR;
        PG8_STAGE(PG8_SB(1, 0), cB + kstep, voffB); PG8_STAGE(PG8_SA(1, 0), cA + kstep, voffA); PG8_STAGE(PG8_SB(1, 1), cB + hstep + kstep, voffB);
        PG8_WAIT_V(6); PG8_BAR;
    }
    for (;;) {
        const bool has_next = S.next(ui + 1, nxt);
        const char* nA = has_next ? (const char*)g.A + (size_t)nxt.pm * tstep : cA; const char* nB = has_next ? (const char*)g.Bt + (size_t)nxt.pn * tstep : cB;
        for (int t = 0; t < nt; t += 2) {
            const bool last = (t == nt - 2);
            const char* a1 = cA + (size_t)(t + 1) * kstep;
            const char* a2 = last ? nA : cA + (size_t)(t + 2) * kstep; const char* b2 = last ? nB : cB + (size_t)(t + 2) * kstep;
            const char* a3 = a2 + kstep; const char* b3 = b2 + kstep;
            if (last && has_next) S.a_ready(nxt);
            if constexpr (SP2) {
            PG8_LDB(B0, 0, 0); PG8_LDB(B1, 0, 1); PG8_SCHED; PG8_LDA(At, 0, 0); PG8_STAGE(PG8_SA(1, 1), a1 + hstep, voffA);
            PG8_WAIT_V(8); PG8_WAIT_L(0); PG8_BAR; PG8_MMA(0, 0, At, B0); PG8_MMA(0, 1, At, B1); PG8_BAR; PG8_SCHED;
            PG8_LDA(At, 0, 1); PG8_STAGE(PG8_SB(0, 0), b2, voffB); PG8_STAGE(PG8_SB(0, 1), b2 + hstep, voffB); PG8_STAGE(PG8_SA(0, 0), a2, voffA);
            PG8_WAIT_V(8); PG8_WAIT_L(0); PG8_BAR; PG8_MMA(1, 0, At, B0); PG8_MMA(1, 1, At, B1); PG8_BAR; PG8_SCHED;
            PG8_LDB(B0, 1, 0); PG8_LDB(B1, 1, 1); PG8_SCHED; PG8_LDA(At, 1, 0); PG8_STAGE(PG8_SA(0, 1), a2 + hstep, voffA);
            PG8_WAIT_V(8); PG8_WAIT_L(0); PG8_BAR; PG8_MMA(0, 0, At, B0); PG8_MMA(0, 1, At, B1); PG8_BAR; PG8_SCHED;
            PG8_LDA(At, 1, 1); PG8_STAGE(PG8_SB(1, 0), b3, voffB); PG8_STAGE(PG8_SB(1, 1), b3 + hstep, voffB); PG8_STAGE(PG8_SA(1, 0), a3, voffA);
            PG8_WAIT_V(8); PG8_WAIT_L(0); PG8_BAR; PG8_MMA(1, 0, At, B0); PG8_MMA(1, 1, At, B1); PG8_BAR; PG8_SCHED;
            } else {
            PG8_LDB(B0, 0, 0); PG8_SCHED; PG8_LDA(At, 0, 0); PG8_STAGE(PG8_SA(1, 1), a1 + hstep, voffA);
            PG8_WAIT_L(8); PG8_BAR; PG8_WAIT_L(0); PG8_MMA(0, 0, At, B0); PG8_BAR; PG8_SCHED;
            PG8_LDB(B1, 0, 1); PG8_STAGE(PG8_SB(0, 0), b2, voffB);
            PG8_BAR; PG8_WAIT_L(0); PG8_MMA(0, 1, At, B1); PG8_BAR;
            PG8_LDA(At, 0, 1); PG8_STAGE(PG8_SA(0, 0), a2, voffA);
            PG8_BAR; PG8_WAIT_L(0); PG8_MMA(1, 0, At, B0); PG8_BAR; PG8_SCHED;
            PG8_STAGE(PG8_SB(0, 1), b2 + hstep, voffB);
            PG8_WAIT_V(6); PG8_BAR; PG8_MMA(1, 1, At, B1); PG8_BAR;
            PG8_LDB(B0, 1, 0); PG8_SCHED; PG8_LDA(At, 1, 0); PG8_STAGE(PG8_SA(0, 1), a2 + hstep, voffA);
            PG8_WAIT_L(8); PG8_BAR; PG8_WAIT_L(0); PG8_MMA(0, 0, At, B0); PG8_BAR; PG8_SCHED;
            PG8_LDB(B1, 1, 1); PG8_STAGE(PG8_SB(1, 0), b3, voffB);
            PG8_BAR; PG8_WAIT_L(0); PG8_MMA(0, 1, At, B1); PG8_BAR;
            PG8_LDA(At, 1, 1); PG8_STAGE(PG8_SA(1, 0), a3, voffA);
            PG8_BAR; PG8_WAIT_L(0); PG8_MMA(1, 0, At, B0); PG8_BAR; PG8_SCHED;
            PG8_STAGE(PG8_SB(1, 1), b3 + hstep, voffB);
            PG8_WAIT_V(6); PG8_BAR; PG8_MMA(1, 1, At, B1); PG8_BAR;
            }
        }
        if constexpr (ALIGN_EPI) { if (wr == 0) PG8_BAR; }
        if constexpr (!Epi::AFTER_DRAIN) { E(acc, cur, wr, wc, fr, fq); S.done(cur); }
        if (!has_next) break;
#pragma unroll
        for (int a = 0; a < 2; ++a)
#pragma unroll
            for (int b = 0; b < 2; ++b)
#pragma unroll
                for (int m = 0; m < 4; ++m)
#pragma unroll
                    for (int n = 0; n < 2; ++n) acc[a][b][m][n] = (f32x4){0.f, 0.f, 0.f, 0.f};
        cur = nxt; cA = nA; cB = nB; ++ui;
        if constexpr (ALIGN_EPI) { if (wr == 1) PG8_BAR; }
    }
    PG8_WAIT_V(0);
    if constexpr (!ALIGN_EPI) { if (wr == 0) PG8_BAR; }
    PG8_BAR;
    if constexpr (Epi::AFTER_DRAIN) { E.fused(acc, cur, wr, wc, fr, fq, lds, wid, lane); S.done(cur); }
#undef PG8_SA
#undef PG8_SB
#undef PG8_STAGE
#undef PG8_LDA
#undef PG8_LDB
#undef PG8_MMA
#undef PG8_WAIT_V
#undef PG8_WAIT_L
#undef PG8_BAR
#undef PG8_SCHED
}
}

#ifndef PG8_SP2
#define PG8_SP2 true
#endif
#ifndef PG8_ALIGN
#define PG8_ALIGN true
#endif
#define GAS __attribute__((address_space(1)))
#define LAS __attribute__((address_space(3)))
typedef unsigned short bf16;
typedef unsigned v4u __attribute__((ext_vector_type(4)));
typedef float f32x4 __attribute__((ext_vector_type(4)));
typedef short bf16x8 __attribute__((ext_vector_type(8)));
typedef GAS unsigned gu32;
typedef GAS unsigned long long gu64;
#define RLX_AGENT __ATOMIC_RELAXED, __HIP_MEMORY_SCOPE_AGENT
#define LDS_WAIT() asm volatile("s_waitcnt lgkmcnt(0)" ::: "memory")
#define VM_WAIT() asm volatile("s_waitcnt vmcnt(0)" ::: "memory")
__device__ __forceinline__ unsigned long long rt() { return __builtin_amdgcn_s_memrealtime(); }
__device__ __forceinline__ unsigned f2bf(float f) { unsigned u = __builtin_bit_cast(unsigned, f); return (u + 0x7fffu + ((u >> 16) & 1u)) >> 16; }
__device__ __forceinline__ unsigned pk2(float lo, float hi) { return f2bf(lo) | (f2bf(hi) << 16); }

#define XB_TMO      128
#define XB_XCNT(j)  (256  + 64 * (j))
#define XB_XSUB(j)  (1280 + 64 * (j))
#define XB_XGEN(j)  (2304 + 64 * (j))
#define XB_TOP      3328
#define XB_TOPGEN   3392
#define XCD_BAR_WORDS 3456
#define XB_SPIN_CAP (1u << 18)

__device__ __forceinline__ unsigned xb_ld(unsigned* p)              { return __hip_atomic_load(p, __ATOMIC_RELAXED, __HIP_MEMORY_SCOPE_AGENT); }
__device__ __forceinline__ unsigned xb_add(unsigned* p, unsigned v) { return __hip_atomic_fetch_add(p, v, __ATOMIC_RELAXED, __HIP_MEMORY_SCOPE_AGENT); }
__device__ __forceinline__ unsigned xb_xcc_id() { return (unsigned)__builtin_amdgcn_s_getreg((3 << 11) | 20) & 0xFu; }
#define XB_SPIN(cond, bar) do { unsigned _sp = 0; while (cond) { __builtin_amdgcn_s_sleep(1); \
    if ((++_sp & 255u) == 0u) { if (xb_ld(&(bar)[XB_TMO])) break; if (_sp > XB_SPIN_CAP) { atomicAdd(&(bar)[XB_TMO], 1u); break; } } } } while (0)

struct XcdBarrier {
    unsigned* bar; unsigned x;
    volatile LAS unsigned* st;
};

__device__ __forceinline__ XcdBarrier xcd_barrier_post(unsigned* bar, volatile LAS unsigned* st) {
    XcdBarrier b; b.bar = bar; b.x = xb_xcc_id(); b.st = st;
    if (threadIdx.x == 0) (void)xb_add(&bar[XB_XCNT(b.x)], 1u);
    return b;
}
__device__ __forceinline__ void xcd_barrier_complete(unsigned* bar, unsigned x, unsigned& nloc, unsigned& nx) {
    const unsigned G = gridDim.x * gridDim.y * gridDim.z;
    unsigned sum, cnt, mine, sp = 0u;
    for (;;) {
        sum = 0u; cnt = 0u; mine = 0u;
#pragma unroll
        for (unsigned j = 0; j < 16; ++j) { const unsigned c = xb_ld(&bar[XB_XCNT(j)]); sum += c; cnt += (c > 0u) ? 1u : 0u; mine = (j == x) ? c : mine; }
        if (sum == G) break;
        __builtin_amdgcn_s_sleep(1);
        if ((++sp & 255u) == 0u) { if (xb_ld(&bar[XB_TMO])) break; if (sp > XB_SPIN_CAP) { atomicAdd(&bar[XB_TMO], 1u); break; } }
    }
    nloc = mine > 0u ? mine : 1u; nx = cnt > 0u ? cnt : 1u;
}

__device__ __forceinline__ void xcd_barrier(const XcdBarrier& b) {
    asm volatile("s_waitcnt vmcnt(0)" ::: "memory");
    __syncthreads();
    if (threadIdx.x == 0) {
        unsigned* bar = b.bar;
        __builtin_amdgcn_s_waitcnt(0);
        unsigned nloc = b.st[0], nx = b.st[1];
        if (nloc == 0u) { xcd_barrier_complete(bar, b.x, nloc, nx); b.st[0] = nloc; b.st[1] = nx; }
        const unsigned old = xb_add(&bar[XB_XSUB(b.x)], 1u);
        const unsigned gen = old / nloc;
        if (old + 1u == (gen + 1u) * nloc) {
            __builtin_amdgcn_fence(__ATOMIC_RELEASE, "agent");
            asm volatile("s_waitcnt vmcnt(0)" ::: "memory");
            const unsigned og = xb_add(&bar[XB_TOP], 1u);
            const unsigned tg = og / nx;
            if (og + 1u == (tg + 1u) * nx) xb_add(&bar[XB_TOPGEN], 1u);
            else XB_SPIN(xb_ld(&bar[XB_TOPGEN]) == tg, bar);
            __builtin_amdgcn_fence(__ATOMIC_ACQUIRE, "agent");
            xb_add(&bar[XB_XGEN(b.x)], 1u);
            asm volatile("s_waitcnt vmcnt(0)" ::: "memory");
        } else {
            XB_SPIN(xb_ld(&bar[XB_XGEN(b.x)]) == gen, bar);
            __builtin_amdgcn_fence(__ATOMIC_ACQUIRE, "agent");
            asm volatile("s_waitcnt vmcnt(0)" ::: "memory");
        }
    }
    __syncthreads();
}

constexpr int NWAVES = 8;
constexpr int BATCH = 8, SEQ = 4096, DMODEL = 1024, MTOK = BATCH * SEQ, INC = 3072, DFF = 2816, NGU = 2 * DFF;
constexpr float EPS = 1e-6f;
constexpr size_t MiB = 1u << 20;
constexpr size_t WS_CTL = 0, CTL_ZERO_BYTES = 65536;
constexpr size_t WS_WIN = 2 * MiB, WS_WOUT = 8 * MiB, WS_WGU = 10 * MiB, WS_WD = 22 * MiB, WS_SSQ = 28 * MiB;
constexpr size_t WS_PROJ = 32 * MiB;
constexpr size_t WS_XN = 224 * MiB;
constexpr size_t WS_MIX = 352 * MiB;
constexpr size_t WS_RINV = 30 * MiB;
constexpr size_t WS_XH = 288 * MiB;
constexpr size_t WS_ACT = 32 * MiB;
constexpr size_t WS_END = 416 * MiB;
constexpr int CW_BAR = 4096;
constexpr int RING_OFF = 0, RING_BYTES = 131072;
constexpr int LDSCTL_OFF = RING_BYTES, MISC_OFF = LDSCTL_OFF + 320;
constexpr int TAB_OFF = RING_BYTES + 1024, WSF_OFF = RING_BYTES + 5120, RSTD_OFF = RING_BYTES + 9216;
constexpr int LDS_BYTES = 147456;

namespace att {
using bf16x8 = __attribute__((ext_vector_type(8))) short;
using s16x4 = __attribute__((ext_vector_type(4))) short;
using f32x16 = __attribute__((ext_vector_type(16))) float;
using f32x4v = __attribute__((ext_vector_type(4))) float;
using u32x4 = __attribute__((ext_vector_type(4))) unsigned;
using u32x2 = __attribute__((ext_vector_type(2))) unsigned;
typedef unsigned short bf16;
constexpr int SEQ = 4096, PP = 512  , MP = 1024  ;
constexpr float LOG2E = 1.4426950408889634f, EPS = 1e-6f;
#define MFMA32(a, b, c) __builtin_amdgcn_mfma_f32_32x32x16_bf16(a, b, c, 0, 0, 0)
#define ATT_WAIT_BAR() asm volatile("s_waitcnt vmcnt(0) lgkmcnt(0)\n\ts_barrier" ::: "memory")
#define ATT_LDS_BAR() asm volatile("s_waitcnt lgkmcnt(0)\n\ts_barrier" ::: "memory")
typedef __attribute__((address_space(3))) const char* lds_cptr;
typedef __attribute__((address_space(3))) char* lds_ptr;
typedef short v4i16_t __attribute__((ext_vector_type(4)));
__device__ __forceinline__ int crow(int r, int hi) { return (r & 3) + 8 * (r >> 2) + 4 * hi; }
__device__ __forceinline__ void glds16(const void* gsrc, unsigned lds_dst) { unsigned keep;
#if MK_PROBE_DMA2
    asm volatile("s_mov_b32 %0, m0\n\ts_mov_b32 m0, %2\n\ts_nop 0\n\tglobal_load_lds_dwordx4 %1, off\n\tglobal_load_lds_dwordx4 %1, off\n\ts_mov_b32 m0, %0" : "=&s"(keep) : "v"(gsrc), "s"(lds_dst) : "memory"); }
#else
    asm volatile("s_mov_b32 %0, m0\n\ts_mov_b32 m0, %2\n\ts_nop 0\n\tglobal_load_lds_dwordx4 %1, off\n\ts_mov_b32 m0, %0" : "=&s"(keep) : "v"(gsrc), "s"(lds_dst) : "memory"); }
#endif
__device__ __forceinline__ s16x4 vtr(lds_cptr p) { return __builtin_bit_cast(s16x4, __builtin_amdgcn_ds_read_tr16_b64_v4i16((__attribute__((address_space(3))) v4i16_t*)p)); }
typedef float f32x2_t __attribute__((ext_vector_type(2))); typedef __bf16 bf16x2_t __attribute__((ext_vector_type(2)));
__device__ __forceinline__ unsigned cvtpk(float lo, float hi) { f32x2_t v = {lo, hi}; bf16x2_t b = __builtin_convertvector(v, bf16x2_t); return __builtin_bit_cast(unsigned, b); }
__device__ __forceinline__ float halves_max(float m) { auto rr = __builtin_amdgcn_permlane32_swap(__float_as_uint(m), __float_as_uint(m), false, false); return fmaxf(__uint_as_float(rr[0]), __uint_as_float(rr[1])); }
__device__ __forceinline__ float halves_sum(float m) { auto rr = __builtin_amdgcn_permlane32_swap(__float_as_uint(m), __float_as_uint(m), false, false); return __uint_as_float(rr[0]) + __uint_as_float(rr[1]); }
__device__ __forceinline__ int t5_bucket(int rel) {
    const int n = rel < 0 ? -rel : rel; int b;
    if (n < 8) b = n; else if (n < 12) b = 8; else if (n < 16) b = 9; else if (n < 23) b = 10; else if (n < 32) b = 11;
    else if (n < 46) b = 12; else if (n < 64) b = 13; else if (n < 91) b = 14; else b = 15;
    return b + (rel > 0 ? 16 : 0);
}
__device__ __forceinline__ float rowmax32(const f32x16& p0, const f32x16& p1) {
    float a = fmaxf(fmaxf(p0[0], p0[1]), p1[0]), b = fmaxf(fmaxf(p0[2], p0[3]), p1[1]); a = fmaxf(fmaxf(a, p1[2]), p1[3]);
#pragma unroll
    for (int r = 4; r < 16; r += 4) { a = fmaxf(fmaxf(a, p0[r]), p0[r + 1]); b = fmaxf(fmaxf(b, p0[r + 2]), p0[r + 3]); a = fmaxf(fmaxf(a, p1[r]), p1[r + 1]); b = fmaxf(fmaxf(b, p1[r + 2]), p1[r + 3]); }
    return halves_max(fmaxf(a, b));
}
#define PACK4(P, B) (u32x4){cvtpk(P[B], P[B + 1]), cvtpk(P[B + 2], P[B + 3]), cvtpk(P[B + 4], P[B + 5]), cvtpk(P[B + 6], P[B + 7])}

template <int THR> __device__ __forceinline__ void diff_unit(int b, int h, int u, const bf16* DQ, const bf16* DK, const bf16* DV, bf16* MIX, lds_cptr tabh, float bfar, float mbound, float lam, const float* onw,
                                                           lds_ptr shm, lds_ptr wsfb, bf16x8 (&qr)[4], bool pre, int nb, int nh, int nu) {
    const int tid = threadIdx.x; int lane = tid & 63; asm volatile("" : "+v"(lane));
    const int r32 = lane & 31, hi = lane >> 5; const int wid = __builtin_amdgcn_readfirstlane(tid >> 6), rbk = wid & 3, c = wid >> 2;
    const long rowbase = (long)b * SEQ; const int q0w = u * 128 + rbk * 32, cw = q0w >> 6, NT = 2 * u + 2;
    const unsigned lds0 = (unsigned)(uintptr_t)shm;
    constexpr int KS = 16384, VOFF = 49152;
    __attribute__((address_space(3))) float* wsf = (__attribute__((address_space(3))) float*)(wsfb) + wid * 128;
    const bf16* ksrc = DK + ((size_t)((b * 4 + h) * 64) << 13) + wid * 1024 + lane * 8;
    const bf16* vsrc = DV + ((size_t)((b * 4 + h) * 64) << 13) + wid * 1024 + lane * 8;
#define DMA_K(t, off) do { const unsigned d_ = (unsigned)__builtin_amdgcn_readfirstlane(lds0 + (off) + wid * 2048); glds16(ksrc + ((long)(t) << 13), d_); glds16(ksrc + ((long)(t) << 13) + 512, d_ + 1024); } while (0)
#define DMA_V(t, off) do { const unsigned d_ = (unsigned)__builtin_amdgcn_readfirstlane(lds0 + VOFF + (off) + wid * 2048); glds16(vsrc + ((long)(t) << 13), d_); glds16(vsrc + ((long)(t) << 13) + 512, d_ + 1024); } while (0)
#if MK_PROBE_BAR2
#define WAIT_BAR(N) asm volatile("s_waitcnt vmcnt(" #N ") lgkmcnt(0)\n\ts_barrier\n\ts_barrier" ::: "memory")
#else
#define WAIT_BAR(N) asm volatile("s_waitcnt vmcnt(" #N ") lgkmcnt(0)\n\ts_barrier" ::: "memory")
#endif
#define SBAR() __builtin_amdgcn_sched_barrier(0)
#define PIN(x) asm volatile("" : "+v"(x))
    if (!pre) {
        const bf16* qp = DQ + (rowbase + q0w + r32) * PP + h * 128 + c * 64 + hi * 8;
#pragma unroll
        for (int d0 = 0; d0 < 4; ++d0) qr[d0] = *reinterpret_cast<const bf16x8*>(qp + d0 * 16);
        DMA_K(0, 0); DMA_V(0, 0); DMA_K(1, KS); }
    f32x16 o[4];
#pragma unroll
    for (int d = 0; d < 4; ++d) o[d] = f32x16{};
    float mhat = 0.f, l = 0.f; bool resc = false;
    f32x16 negm;
#pragma unroll
    for (int r = 0; r < 16; ++r) negm[r] = bfar;
    PIN(negm);
    const lds_cptr kp = (lds_cptr)shm + (c * 8 + hi) * 1024 + r32 * 16;
    const lds_cptr vp = (lds_cptr)shm + VOFF + ((lane >> 4) & 1) * 32 + (lane & 3) * 8 + (4 * hi + ((lane & 15) >> 2)) * 64;
    int off_prev = 2 * KS, off_cur = 0, off_next = KS;
#define ROT() do { off_prev = off_cur; off_cur = off_next; off_next = (off_next == 2 * KS) ? 0 : off_next + KS; } while (0)
#define LDK(i) (*(const __attribute__((address_space(3))) bf16x8*)(kq_ + ((i) >> 1) * 2048 + ((i) & 1) * 512))
#define LDVF(dst, j) do { const s16x4 lo_ = vtr(vq_ + ((j) >> 2) * 4096 + ((j) & 3) * 1024), hh_ = vtr(vq_ + ((j) >> 2) * 4096 + ((j) & 3) * 1024 + 512); \
        dst = (bf16x8){lo_[0], lo_[1], lo_[2], lo_[3], hh_[0], hh_[1], hh_[2], hh_[3]}; } while (0)
#define ISSUE(s) do { if ((s) + 2 < NT) DMA_K((s) + 2, off_prev); if ((s) + 1 < NT) DMA_V((s) + 1, off_next); } while (0)
#define ENDW(s) do { if ((s) + 2 < NT) WAIT_BAR(4); else if ((s) + 1 < NT) WAIT_BAR(2); else WAIT_BAR(0); } while (0)
#define NEARBIAS(C0, C1, t) do { if ((t) >= cw - 2) { const __attribute__((address_space(3))) float* tb_ = (const __attribute__((address_space(3))) float*)tabh + (64 * (t) - (q0w + r32) + 4 * hi + 191); \
        _Pragma("unroll") for (int r = 0; r < 16; ++r) { C0[r] += tb_[(r & 3) + 8 * (r >> 2)]; C1[r] += tb_[32 + (r & 3) + 8 * (r >> 2)]; } } } while (0)
#define DECIDE(C0, C1, FIRST) do { const float rm_ = rowmax32(C0, C1); resc = false; \
        if ((FIRST) || __any(rm_ > (float)THR)) { const float dl_ = (FIRST) ? rm_ : fmaxf(rm_, 0.f); mhat += dl_; \
            _Pragma("unroll") for (int r = 0; r < 16; ++r) { C0[r] -= dl_; C1[r] -= dl_; } \
            _Pragma("unroll") for (int r = 0; r < 16; ++r) negm[r] = bfar - mhat; PIN(negm); \
            if (!(FIRST)) { const float f_ = __builtin_amdgcn_exp2f(-dl_); l *= f_; if (hi == 0) wsf[r32] = f_; resc = true; } } } while (0)
#define RESC() do { if (resc) { asm volatile("s_waitcnt lgkmcnt(0)" ::: "memory"); \
        _Pragma("unroll") for (int r = 0; r < 16; ++r) { const float fr_ = wsf[crow(r, hi)]; _Pragma("unroll") for (int d = 0; d < 4; ++d) o[d][r] *= fr_; } \
        asm volatile("s_waitcnt lgkmcnt(0)" ::: "memory"); } } while (0)
    u32x4 pw0, pw1, pw2, pw3; float dum0_ = 0.f, dum1_ = 0.f;
#define GAPA(MF, KR, E, B, PW, I0, PE, PB) do { MF; KR; sacc_ += E[B]; sacc_ += E[B + 1]; sacc_ += E[B + 2]; sacc_ += E[B + 3]; PIN(sacc_); \
        PW[I0] = cvtpk(PE[PB], PE[PB + 1]); PW[I0 + 1] = cvtpk(PE[PB + 2], PE[PB + 3]); PIN(PW); SBAR(); } while (0)
#define GAPB(MF, VR, X, B) do { MF; VR; X[B] = __builtin_amdgcn_exp2f(X[B]); X[B + 1] = __builtin_amdgcn_exp2f(X[B + 1]); PIN(X); if (MK_PROBE_DFVALU) asm volatile("v_add_f32 %0, %0, %0\n\tv_add_f32 %1, %1, %1" : "+v"(dum0_), "+v"(dum1_)); SBAR(); } while (0)
#define QKT(C0, C1) do { const lds_cptr kq_ = kp + off_cur; \
        _Pragma("unroll") for (int d0 = 0; d0 < 4; ++d0) { const bf16x8 k0_ = LDK(2 * d0), k1_ = LDK(2 * d0 + 1); \
            if (d0 == 0) { C0 = MFMA32(k0_, qr[0], negm); C1 = MFMA32(k1_, qr[0], negm); } else { C0 = MFMA32(k0_, qr[d0], C0); C1 = MFMA32(k1_, qr[d0], C1); } } } while (0)
#define PVDRAIN(E0, E1) do { float sacc_ = 0.f; _Pragma("unroll") for (int r = 0; r < 16; ++r) sacc_ += E0[r] + E1[r]; l += sacc_; \
        pw0 = PACK4(E0, 0); pw1 = PACK4(E0, 8); pw2 = PACK4(E1, 0); pw3 = PACK4(E1, 8); SBAR(); \
        const lds_cptr vq_ = vp + off_prev; \
        _Pragma("unroll") for (int d0 = 0; d0 < 4; ++d0) { bf16x8 va_, vb_, vc_, vd_; LDVF(va_, 4 * d0); LDVF(vb_, 4 * d0 + 1); LDVF(vc_, 4 * d0 + 2); LDVF(vd_, 4 * d0 + 3); \
            o[d0] = MFMA32(__builtin_bit_cast(bf16x8, pw0), va_, o[d0]); o[d0] = MFMA32(__builtin_bit_cast(bf16x8, pw1), vb_, o[d0]); \
            o[d0] = MFMA32(__builtin_bit_cast(bf16x8, pw2), vc_, o[d0]); o[d0] = MFMA32(__builtin_bit_cast(bf16x8, pw3), vd_, o[d0]); SBAR(); } } while (0)
#define STEP(C0, C1, E0, E1, s) do { SBAR(); \
        const lds_cptr kq_ = kp + off_cur; const lds_cptr vq_ = vp + off_prev; \
        bf16x8 ka_ = LDK(0), kb_ = LDK(1), kc_, kd_, va_, vb_; SBAR(); \
        float sacc_ = E0[0] + E0[1]; \
        GAPA(C0 = MFMA32(ka_, qr[0], negm), kc_ = LDK(2), E0, 2,  pw0, 0, E0, 0); \
        GAPA(C1 = MFMA32(kb_, qr[0], negm), kd_ = LDK(3), E0, 6,  pw0, 2, E0, 4); \
        if ((s) + 2 < NT) DMA_K((s) + 2, off_prev); \
        GAPA(C0 = MFMA32(kc_, qr[1], C0),   ka_ = LDK(4), E0, 10, pw1, 0, E0, 8); \
        { MFMA_LAST4_(C1, kd_, 1); kb_ = LDK(5); sacc_ += E0[14]; sacc_ += E0[15]; sacc_ += E1[0]; sacc_ += E1[1]; PIN(sacc_); pw1[2] = cvtpk(E0[12], E0[13]); pw1[3] = cvtpk(E0[14], E0[15]); PIN(pw1); SBAR(); } \
        GAPA(C0 = MFMA32(ka_, qr[2], C0),   kc_ = LDK(6), E1, 2,  pw2, 0, E1, 0); \
        GAPA(C1 = MFMA32(kb_, qr[2], C1),   kd_ = LDK(7), E1, 6,  pw2, 2, E1, 4); \
        if ((s) + 1 < NT) DMA_V((s) + 1, off_next); \
        GAPA(C0 = MFMA32(kc_, qr[3], C0),   LDVF(va_, 0), E1, 10, pw3, 0, E1, 8); \
        { C1 = MFMA32(kd_, qr[3], C1); LDVF(vb_, 1); sacc_ += E1[14]; sacc_ += E1[15]; PIN(sacc_); pw3[2] = cvtpk(E1[12], E1[13]); pw3[3] = cvtpk(E1[14], E1[15]); PIN(pw3); SBAR(); } \
        l += sacc_; \
        NEARBIAS(C0, C1, s); \
        resc = false; if (chk) DECIDE(C0, C1, false); \
        SBAR(); if (MK_DIFF_PRIO_B) __builtin_amdgcn_s_setprio(1); \
        GAPB(o[0] = MFMA32(__builtin_bit_cast(bf16x8, pw0), va_, o[0]), LDVF(va_, 2),  C0, 0); \
        GAPB(o[0] = MFMA32(__builtin_bit_cast(bf16x8, pw1), vb_, o[0]), LDVF(vb_, 3),  C0, 2); \
        GAPB(o[0] = MFMA32(__builtin_bit_cast(bf16x8, pw2), va_, o[0]), LDVF(va_, 4),  C0, 4); \
        GAPB(o[0] = MFMA32(__builtin_bit_cast(bf16x8, pw3), vb_, o[0]), LDVF(vb_, 5),  C0, 6); \
        GAPB(o[1] = MFMA32(__builtin_bit_cast(bf16x8, pw0), va_, o[1]), LDVF(va_, 6),  C0, 8); \
        GAPB(o[1] = MFMA32(__builtin_bit_cast(bf16x8, pw1), vb_, o[1]), LDVF(vb_, 7),  C0, 10); \
        GAPB(o[1] = MFMA32(__builtin_bit_cast(bf16x8, pw2), va_, o[1]), LDVF(va_, 8),  C0, 12); \
        GAPB(o[1] = MFMA32(__builtin_bit_cast(bf16x8, pw3), vb_, o[1]), LDVF(vb_, 9),  C0, 14); \
        GAPB(o[2] = MFMA32(__builtin_bit_cast(bf16x8, pw0), va_, o[2]), LDVF(va_, 10), C1, 0); \
        GAPB(o[2] = MFMA32(__builtin_bit_cast(bf16x8, pw1), vb_, o[2]), LDVF(vb_, 11), C1, 2); \
        GAPB(o[2] = MFMA32(__builtin_bit_cast(bf16x8, pw2), va_, o[2]), LDVF(va_, 12), C1, 4); \
        GAPB(o[2] = MFMA32(__builtin_bit_cast(bf16x8, pw3), vb_, o[2]), LDVF(vb_, 13), C1, 6); \
        GAPB(o[3] = MFMA32(__builtin_bit_cast(bf16x8, pw0), va_, o[3]), LDVF(va_, 14), C1, 8); \
        GAPB(o[3] = MFMA32(__builtin_bit_cast(bf16x8, pw1), vb_, o[3]), LDVF(vb_, 15), C1, 10); \
        GAPB(o[3] = MFMA32(__builtin_bit_cast(bf16x8, pw2), va_, o[3]), (void)0,       C1, 12); \
        GAPB(o[3] = MFMA32(__builtin_bit_cast(bf16x8, pw3), vb_, o[3]), (void)0,       C1, 14); \
        if (MK_DIFF_PRIO_B) __builtin_amdgcn_s_setprio(0); \
    } while (0)
#define MFMA_LAST4_(C1, kd_, q) C1 = MFMA32(kd_, qr[q], C1)
    f32x16 pA0, pA1, pB0, pB1;
    if (MK_DIFF_PRIO_STATIC && wid >= 4) __builtin_amdgcn_s_setprio(1);
    WAIT_BAR(4);
    QKT(pA0, pA1); ISSUE(0); NEARBIAS(pA0, pA1, 0); DECIDE(pA0, pA1, true);
    const bool chk = __any(mbound - mhat > 90.f);
#pragma unroll
    for (int r = 0; r < 16; ++r) { pA0[r] = __builtin_amdgcn_exp2f(pA0[r]); pA1[r] = __builtin_amdgcn_exp2f(pA1[r]); }
    ENDW(0); ROT();
    int s = 1;
    for (; s + 1 <= cw; s += 2) {
        STEP(pB0, pB1, pA0, pA1, s);     ENDW(s);     RESC(); ROT();
        STEP(pA0, pA1, pB0, pB1, s + 1); ENDW(s + 1); RESC(); ROT();
    }
    if (s <= cw) { STEP(pB0, pB1, pA0, pA1, s); ENDW(s); RESC(); ROT(); ++s; }
    else {
#pragma unroll
        for (int r = 0; r < 16; ++r) { pB0[r] = pA0[r]; pB1[r] = pA1[r]; } }
    PVDRAIN(pB0, pB1);
    if (s < NT) { ISSUE(s); ENDW(s); ROT(); }
#undef MFMA_LAST4_
#undef STEP
#undef PVDRAIN
#undef QKT
#undef GAPA
#undef GAPB
#undef RESC
#undef DECIDE
#undef NEARBIAS
#undef ENDW
#undef ISSUE
#undef LDVF
#undef LDK
#undef ROT
#undef DMA_K
#undef DMA_V
    if (MK_DIFF_PRIO_STATIC) __builtin_amdgcn_s_setprio(0);
    l = halves_sum(l);
    int r32e = r32, hie = hi; asm volatile("" : "+v"(r32e), "+v"(hie));
    if (hie == 0) wsf[r32e] = (c ? lam : 1.0f) * __builtin_amdgcn_rcpf(l);
    ATT_WAIT_BAR();
    if (nu >= 0) {
        const bf16* ksn = DK + ((size_t)((nb * 4 + nh) * 64) << 13) + wid * 1024 + lane * 8; const bf16* vsn = DV + ((size_t)((nb * 4 + nh) * 64) << 13) + wid * 1024 + lane * 8;
        const unsigned dk_ = (unsigned)__builtin_amdgcn_readfirstlane(lds0 + wid * 2048), dv_ = (unsigned)__builtin_amdgcn_readfirstlane(lds0 + VOFF + wid * 2048);
        glds16(ksn, dk_); glds16(ksn + 512, dk_ + 1024); glds16(vsn, dv_); glds16(vsn + 512, dv_ + 1024); glds16(ksn + 8192, dk_ + KS); glds16(ksn + 8192 + 512, dk_ + KS + 1024);
        const bf16* qn = DQ + ((long)nb * SEQ + nu * 128 + rbk * 32 + r32) * PP + nh * 128 + c * 64 + hi * 8;
#pragma unroll
        for (int d0 = 0; d0 < 4; ++d0) qr[d0] = *reinterpret_cast<const bf16x8*>(qn + d0 * 16); }
    const int k16 = r32e & 15, rsel = 2 * hie + (r32e >> 4);
    const f32x4v wv0 = *(const f32x4v*)(onw + 8 * k16), wv1 = *(const f32x4v*)(onw + 8 * k16 + 4);
    lds_ptr stg = shm + 65536 + rbk * 16384;
#define DSTG(q, d) ((__attribute__((address_space(3))) float*)(stg + (q) * 512 + (((8 * (d) + (r32e >> 2)) ^ ((q) & 15)) << 4) + (r32e & 3) * 4))
    if (c == 0) {
#pragma unroll
        for (int r = 0; r < 16; ++r) { const int q = crow(r, hie); const float a = wsf[q]; *DSTG(q, 2) = o[2][r] * a; *DSTG(q, 3) = o[3][r] * a; } }
    else {
#pragma unroll
        for (int r = 0; r < 16; ++r) { const int q = crow(r, hie); const float a = wsf[q]; *DSTG(q, 0) = o[0][r] * a; *DSTG(q, 1) = o[1][r] * a; } }
    ATT_LDS_BAR();
    if (c == 0) {
#pragma unroll
        for (int r = 0; r < 16; ++r) { const int q = crow(r, hie); const float a = wsf[q]; *DSTG(q, 0) = o[0][r] * a - *DSTG(q, 0); *DSTG(q, 1) = o[1][r] * a - *DSTG(q, 1); } }
    else {
#pragma unroll
        for (int r = 0; r < 16; ++r) { const int q = crow(r, hie); const float a = wsf[q]; *DSTG(q, 2) = *DSTG(q, 2) - o[2][r] * a; *DSTG(q, 3) = *DSTG(q, 3) - o[3][r] * a; } }
#undef DSTG
    ATT_LDS_BAR();
    { float ss = 0.f;
#pragma unroll
      for (int k = 0; k < 16; ++k) { const f32x4v v = *(const __attribute__((address_space(3))) f32x4v*)(stg + r32e * 512 + (((16 * hie + k) ^ (r32e & 15)) << 4)); ss += (v[0] * v[0] + v[1] * v[1]) + (v[2] * v[2] + v[3] * v[3]); }
      ss = halves_sum(ss);
      if (hie == 0) wsf[64 + r32e] = 0.8f * __builtin_amdgcn_rsqf(ss * (1.0f / 128.0f) + EPS);
      asm volatile("s_waitcnt lgkmcnt(0)" ::: "memory");
      bf16* op = MIX + (rowbase + q0w) * MP + h * 128 + 8 * k16;
      asm volatile("s_waitcnt vmcnt(0)" ::: "memory");
#pragma unroll
      for (int i = 0; i < 4; ++i) { const int q = 16 * c + 4 * i + rsel; const float rs = wsf[64 + q];
          const f32x4v v0 = *(const __attribute__((address_space(3))) f32x4v*)(stg + q * 512 + (((2 * k16) ^ (q & 15)) << 4));
          const f32x4v v1 = *(const __attribute__((address_space(3))) f32x4v*)(stg + q * 512 + (((2 * k16 + 1) ^ (q & 15)) << 4));
          u32x4 w; w.x = cvtpk(v0[0] * rs * wv0[0], v0[1] * rs * wv0[1]); w.y = cvtpk(v0[2] * rs * wv0[2], v0[3] * rs * wv0[3]);
          w.z = cvtpk(v1[0] * rs * wv1[0], v1[1] * rs * wv1[1]); w.w = cvtpk(v1[2] * rs * wv1[2], v1[3] * rs * wv1[3]);
          *(u32x4*)(op + (long)q * MP) = w; }
    }
    ATT_LDS_BAR();
#undef WAIT_BAR
#undef SBAR
#undef PIN
}

__device__ __forceinline__ void sb_item(int b, int h, int rb, const bf16* SQ, const bf16* SK, const bf16* SV, bf16* MIX, const float* onw, lds_ptr shm, lds_ptr wsfb) {
    int lane = threadIdx.x & 63; asm volatile("" : "+v"(lane));
    const int r32 = lane & 31, hi = lane >> 5;
    const long rowbase = (long)b * SEQ; const int q0w = rb * 32, tq = q0w >> 6, qloc = (q0w & 63) + r32;
    const unsigned lds0 = (unsigned)__builtin_amdgcn_readfirstlane((unsigned)(uintptr_t)shm);
    __attribute__((address_space(3))) float* wsf = (__attribute__((address_space(3))) float*)(wsfb);
    const bf16* ksrc = SK + ((size_t)((b * 8 + h) * 64) << 12) + hi * 512 + (16 * ((r32 >> 2) & 1) + (r32 & 3) + 4 * (r32 >> 3)) * 8;
    const bf16* vsrc = SV + ((size_t)((b * 8 + h) * 64) << 12) + lane * 8;
#define SB_DMA_V(t, buf) do { _Pragma("unroll") for (int i_ = 0; i_ < 8; ++i_) glds16(vsrc + ((long)(t) << 12) + i_ * 512, lds0 + (buf) * 8192 + i_ * 1024); } while (0)
#define SB_LD_K(dst, t) do { _Pragma("unroll") for (int d_ = 0; d_ < 4; ++d_) { dst[2 * d_] = *reinterpret_cast<const bf16x8*>(ksrc + ((long)(t) << 12) + d_ * 1024); \
        dst[2 * d_ + 1] = *reinterpret_cast<const bf16x8*>(ksrc + ((long)(t) << 12) + d_ * 1024 + 256); } } while (0)
    bf16x8 qr[4], kfA[8], kfB[8];
    asm volatile("s_waitcnt lgkmcnt(0)" ::: "memory");
    SB_DMA_V(tq, 0); SB_LD_K(kfA, tq);
    { const bf16* qp = SQ + (rowbase + q0w + r32) * PP + h * 64 + hi * 8;
#pragma unroll
      for (int d0 = 0; d0 < 4; ++d0) qr[d0] = *reinterpret_cast<const bf16x8*>(qp + d0 * 16); }
    f32x16 o[2]; o[0] = f32x16{}; o[1] = f32x16{};
    float carry = 1.0f;
    const lds_cptr vp = (lds_cptr)shm + ((lane >> 4) & 1) * 32 + (lane & 3) * 8 + (16 * hi + ((lane & 15) >> 2)) * 64;
#define SB_TILE(KU, KL, DIAG, t) do { \
        const int vb_ = ((tq - (t)) & 1) * 8192; \
        asm volatile("" ::: "memory"); __builtin_amdgcn_s_waitcnt(0x0070); asm volatile("" ::: "memory");     \
        if ((t) > 0) { SB_DMA_V((t) - 1, ((tq - (t)) & 1) ^ 1); SB_LD_K(KL, (t) - 1); } \
        f32x16 p0 = f32x16{}, p1 = f32x16{}; \
        _Pragma("unroll") for (int d0 = 0; d0 < 4; ++d0) { p0 = MFMA32(KU[2 * d0], qr[d0], p0); p1 = MFMA32(KU[2 * d0 + 1], qr[d0], p1); } \
        __builtin_amdgcn_sched_barrier(0); \
          \
        f32x16 b0, b1; \
        _Pragma("unroll") for (int r = 0; r < 16; ++r) { \
            { float be = __builtin_amdgcn_rcpf(1.0f + __builtin_amdgcn_exp2f(-p0[r])), om = 1.0f - be; \
              if ((DIAG) && 16 * hi + r >= qloc) { be = 0.f; om = 1.f; } p0[r] = be; b0[r] = om; } \
            { float be = __builtin_amdgcn_rcpf(1.0f + __builtin_amdgcn_exp2f(-p1[r])), om = 1.0f - be; \
              if ((DIAG) && 32 + 16 * hi + r >= qloc) { be = 0.f; om = 1.f; } p1[r] = be; b1[r] = om; } } \
          \
        float t1_ = b1[15], t0_ = b0[15]; \
        _Pragma("unroll") for (int r = 14; r >= 0; --r) { p1[r] *= t1_; t1_ *= b1[r]; p0[r] *= t0_; t0_ *= b0[r]; } \
          \
        float o1_, o0_;                                       \
        { auto rr = __builtin_amdgcn_permlane32_swap(__float_as_uint(t1_), __float_as_uint(t1_), false, false); o1_ = __uint_as_float(rr[0] ^ rr[1] ^ __float_as_uint(t1_)); }     \
        { auto rr = __builtin_amdgcn_permlane32_swap(__float_as_uint(t0_), __float_as_uint(t0_), false, false); o0_ = __uint_as_float(rr[0] ^ rr[1] ^ __float_as_uint(t0_)); } \
        const float cu_ = carry * o1_, R1_ = hi ? carry : cu_;     \
        const float cP1_ = cu_ * t1_;                            \
        const float cv_ = cP1_ * o0_, R0_ = hi ? cP1_ : cv_;       \
        carry = cv_ * t0_; \
        _Pragma("unroll") for (int r = 0; r < 16; ++r) { p1[r] *= R1_; p0[r] *= R0_; } \
        if (MK_PROBE_SBVALU) { float x0_ = carry, x1_ = carry, x2_ = carry, x3_ = carry; _Pragma("unroll") for (int i_ = 0; i_ < 16; ++i_) asm volatile("v_add_f32 %0, %0, %0\n\tv_add_f32 %1, %1, %1\n\tv_add_f32 %2, %2, %2\n\tv_add_f32 %3, %3, %3" : "+v"(x0_), "+v"(x1_), "+v"(x2_), "+v"(x3_)); } \
        const u32x4 pw0 = PACK4(p0, 0), pw1 = PACK4(p0, 8), pw2 = PACK4(p1, 0), pw3 = PACK4(p1, 8); \
        __builtin_amdgcn_sched_barrier(0); \
        _Pragma("unroll") for (int d0 = 0; d0 < 2; ++d0) { \
            _Pragma("unroll") for (int ks = 0; ks < 4; ++ks) { const s16x4 lo = vtr(vp + vb_ + d0 * 4096 + (ks >> 1) * 2048 + (ks & 1) * 512), hh = vtr(vp + vb_ + d0 * 4096 + (ks >> 1) * 2048 + (ks & 1) * 512 + 256); \
                const bf16x8 vf = (bf16x8){lo[0], lo[1], lo[2], lo[3], hh[0], hh[1], hh[2], hh[3]}; \
                const u32x4 pk = ks == 0 ? pw0 : ks == 1 ? pw1 : ks == 2 ? pw2 : pw3; \
                o[d0] = MFMA32(__builtin_bit_cast(bf16x8, pk), vf, o[d0]); } \
            __builtin_amdgcn_sched_barrier(0); } \
    } while (0)
#define SB_DONE(t) ((t) == 0 || __all(carry < 1.0e-41f))
    { int t = tq;
      SB_TILE(kfA, kfB, true, t);
      if (!SB_DONE(t)) { --t;
          for (;;) { SB_TILE(kfB, kfA, false, t); if (SB_DONE(t)) break; --t;
                     SB_TILE(kfA, kfB, false, t); if (SB_DONE(t)) break; --t; } } }
#undef SB_DONE
#undef SB_TILE
#undef SB_DMA_V
#undef SB_LD_K
    asm volatile("s_waitcnt vmcnt(0)" ::: "memory");
    asm volatile("s_waitcnt lgkmcnt(0)" ::: "memory");
    int r32e = r32, hie = hi, lanee = lane; asm volatile("" : "+v"(r32e), "+v"(hie), "+v"(lanee));
    { lds_ptr stg = shm;
      const int c8 = lanee & 7, rsel = lanee >> 3;
      const f32x4v wv0 = *(const f32x4v*)(onw + 8 * c8), wv1 = *(const f32x4v*)(onw + 8 * c8 + 4);
#pragma unroll
      for (int r = 0; r < 16; ++r) { const int q = crow(r, hie);
#pragma unroll
          for (int d = 0; d < 2; ++d) *(__attribute__((address_space(3))) float*)(stg + q * 256 + (((8 * d + (r32e >> 2)) ^ (q & 15)) << 4) + (r32e & 3) * 4) = o[d][r]; }
      asm volatile("s_waitcnt lgkmcnt(0)" ::: "memory");
      float ss = 0.f;
#pragma unroll
      for (int k = 0; k < 8; ++k) { const f32x4v v = *(const __attribute__((address_space(3))) f32x4v*)(stg + r32e * 256 + (((8 * hie + k) ^ (r32e & 15)) << 4)); ss += (v[0] * v[0] + v[1] * v[1]) + (v[2] * v[2] + v[3] * v[3]); }
      ss = halves_sum(ss);
      if (hie == 0) wsf[r32e] = __builtin_amdgcn_rsqf(ss * (1.0f / 64.0f) + EPS);
      asm volatile("s_waitcnt lgkmcnt(0)" ::: "memory");
      bf16* op = MIX + (rowbase + q0w) * MP + 512 + h * 64 + 8 * c8;
#pragma unroll
      for (int i = 0; i < 4; ++i) { const int q = 8 * i + rsel; const float rs = wsf[q];
          const f32x4v v0 = *(const __attribute__((address_space(3))) f32x4v*)(stg + q * 256 + (((2 * c8) ^ (q & 15)) << 4));
          const f32x4v v1 = *(const __attribute__((address_space(3))) f32x4v*)(stg + q * 256 + (((2 * c8 + 1) ^ (q & 15)) << 4));
          u32x4 w; w.x = cvtpk(v0[0] * rs * wv0[0], v0[1] * rs * wv0[1]); w.y = cvtpk(v0[2] * rs * wv0[2], v0[3] * rs * wv0[3]);
          w.z = cvtpk(v1[0] * rs * wv1[0], v1[1] * rs * wv1[1]); w.w = cvtpk(v1[2] * rs * wv1[2], v1[3] * rs * wv1[3]);
          *(u32x4*)(op + (long)q * MP) = w; }
      asm volatile("s_waitcnt lgkmcnt(0)" ::: "memory");
    }
}
#undef MFMA32
#undef PACK4
}
struct Frame {
    LAS unsigned char* lds;
    volatile LAS unsigned* MISC;
    gu32* ctl;
    int tid, lane, wave;
    int vcu, G;
};
__device__ __forceinline__ float wave_max(float v) {
    v = fmaxf(v, __builtin_bit_cast(float, __builtin_amdgcn_update_dpp(0, __builtin_bit_cast(int, v), 0x128, 0xf, 0xf, false)));
    v = fmaxf(v, __builtin_bit_cast(float, __builtin_amdgcn_update_dpp(0, __builtin_bit_cast(int, v), 0x124, 0xf, 0xf, false)));
    v = fmaxf(v, __builtin_bit_cast(float, __builtin_amdgcn_update_dpp(0, __builtin_bit_cast(int, v), 0x122, 0xf, 0xf, false)));
    v = fmaxf(v, __builtin_bit_cast(float, __builtin_amdgcn_update_dpp(0, __builtin_bit_cast(int, v), 0x121, 0xf, 0xf, false)));
    { auto a = __builtin_amdgcn_permlane16_swap(__float_as_uint(v), __float_as_uint(v), false, false); v = fmaxf(__uint_as_float(a[0]), __uint_as_float(a[1])); }
    { auto a = __builtin_amdgcn_permlane32_swap(__float_as_uint(v), __float_as_uint(v), false, false); v = fmaxf(__uint_as_float(a[0]), __uint_as_float(a[1])); }
    return v;
}
__device__ __forceinline__ float wave_sum(float v) {
    v += __builtin_bit_cast(float, __builtin_amdgcn_update_dpp(0, __builtin_bit_cast(int, v), 0x128, 0xf, 0xf, false));
    v += __builtin_bit_cast(float, __builtin_amdgcn_update_dpp(0, __builtin_bit_cast(int, v), 0x124, 0xf, 0xf, false));
    v += __builtin_bit_cast(float, __builtin_amdgcn_update_dpp(0, __builtin_bit_cast(int, v), 0x122, 0xf, 0xf, false));
    v += __builtin_bit_cast(float, __builtin_amdgcn_update_dpp(0, __builtin_bit_cast(int, v), 0x121, 0xf, 0xf, false));
    { auto a = __builtin_amdgcn_permlane16_swap(__float_as_uint(v), __float_as_uint(v), false, false); v = __uint_as_float(a[0]) + __uint_as_float(a[1]); }
    { auto a = __builtin_amdgcn_permlane32_swap(__float_as_uint(v), __float_as_uint(v), false, false); v = __uint_as_float(a[0]) + __uint_as_float(a[1]); }
    return v;
}
__device__ __forceinline__ void p0_transpose_item(const float* W, int K, int N, bf16* WT, int k0, int n0, int prow0, const float* ks, LAS float* scr, int lane) {
    f32x4 tv[8]; float sc[8];
#pragma unroll
    for (int i = 0; i < 8; ++i) { const int kk = 8 * i + (lane >> 3); tv[i] = *(const GAS f32x4*)(W + (size_t)(k0 + kk) * N + n0 + 4 * (lane & 7)); sc[i] = ks ? ks[k0 + kk] : 1.0f; }
#pragma unroll
    for (int i = 0; i < 8; ++i) { const int kk = 8 * i + (lane >> 3); f32x4 v = tv[i]; if (ks) v = v * sc[i]; LAS float* d = scr + kk * 33 + 4 * (lane & 7); d[0] = v.x; d[1] = v.y; d[2] = v.z; d[3] = v.w; }
    LDS_WAIT(); asm volatile("" ::: "memory");
    const int c = lane & 7;
#pragma unroll
    for (int j = 0; j < 4; ++j) { const int n = (lane >> 3) + 8 * j; const LAS float* s = scr + (8 * c) * 33 + n;
        v4u o; o.x = pk2(s[0 * 33], s[1 * 33]); o.y = pk2(s[2 * 33], s[3 * 33]); o.z = pk2(s[4 * 33], s[5 * 33]); o.w = pk2(s[6 * 33], s[7 * 33]);
        *(GAS v4u*)(WT + (size_t)(prow0 + n) * K + k0 + 8 * c) = o; }
    LDS_WAIT(); asm volatile("" ::: "memory");
}
template <int NR> __device__ __forceinline__ void rms_rows_load(f32x4 (&v)[NR][4], int lane, const float* xrow) {
#pragma unroll
    for (int r = 0; r < NR; ++r) { const GAS f32x4* xr = (const GAS f32x4*)(xrow + (size_t)r * DMODEL) + lane;
#pragma unroll
        for (int j = 0; j < 4; ++j) v[r][j] = __builtin_nontemporal_load(xr + 64 * j); }
}
template <int NR> __device__ __forceinline__ void rms_rows_finish(const f32x4 (&v)[NR][4], int lane, bf16* orow, float* rinv, int row0) {
#pragma unroll
    for (int r = 0; r < NR; ++r) { float s = 0.f;
#pragma unroll
        for (int j = 0; j < 4; ++j) s += (v[r][j].x * v[r][j].x + v[r][j].y * v[r][j].y) + (v[r][j].z * v[r][j].z + v[r][j].w * v[r][j].w);
        const float ri = sqrtf(wave_sum(s) * (1.f / DMODEL) + EPS), rstd = 1.f / ri;
        if (lane == 0) rinv[pg8::rinv_index(row0 + r)] = ri;
        GAS unsigned long long* o8 = (GAS unsigned long long*)(orow + (size_t)r * DMODEL) + lane;
#pragma unroll
        for (int j = 0; j < 4; ++j) o8[64 * j] = (unsigned long long)pk2(v[r][j].x * rstd, v[r][j].y * rstd) | ((unsigned long long)pk2(v[r][j].z * rstd, v[r][j].w * rstd) << 32); }
}

struct Args { const float* in[17]; float* out; unsigned char* ws; int ph_lo, ph_hi, li, flags; };

__device__ __forceinline__ void p0_prologue(Frame& F, const Args& args, int part) {
    LAS float* scr = (LAS float*)(F.lds + RING_OFF + F.wave * 16384);
    const int gw = F.vcu * NWAVES + F.wave, NGW = F.G * NWAVES;
    unsigned char* ws = args.ws;
    bf16* Win_t = (bf16*)(ws + WS_WIN); bf16* Wout_t = (bf16*)(ws + WS_WOUT); bf16* Wgu_t = (bf16*)(ws + WS_WGU); bf16* Wd_t = (bf16*)(ws + WS_WD);
    constexpr int I_IN = (DMODEL / 64) * (INC / 32), I_OUT = (DMODEL / 64) * (DMODEL / 32), I_G = (DMODEL / 64) * (DFF / 32), I_D = (DFF / 64) * (DMODEL / 32);
    constexpr int NITEMS = I_IN + I_OUT + 2 * I_G + I_D;
    bf16* XN = (bf16*)(ws + WS_XN);
    for (int pass = 0; pass < 2; ++pass) {
    if ((pass == 0) == ((gw & 1) == 0)) {
    for (int it = part ? I_IN + gw : (F.wave < 6 ? F.vcu * 6 + F.wave : I_IN), dj = 0; ; it += F.G * 6) {
            if (part) {
                unsigned j = 0u; if (F.lane == 0) j = __hip_atomic_fetch_add((LAS unsigned*)(F.MISC + 17), 1u, __ATOMIC_RELAXED, __HIP_MEMORY_SCOPE_WORKGROUP);
                j = (unsigned)__builtin_amdgcn_readfirstlane((int)j); it = I_IN + F.vcu * NWAVES + (int)(j & 7u) + (int)(j >> 3) * NGW; (void)dj; }
            if (it >= (part ? NITEMS : I_IN)) break;
            int r = it;
            if (r < I_IN) { const int nblk = INC / 32, kb = r / nblk, nb = r % nblk, n0 = 32 * nb; const int L0 = n0 & 255, wc = L0 >> 6, bj = (L0 >> 5) & 1;
                p0_transpose_item(args.in[2], DMODEL, INC, Win_t, 64 * kb, n0, (n0 & ~255) + 128 * bj + 32 * wc, args.in[1], scr, F.lane); continue; } r -= I_IN;
            if (r < I_OUT) { const int nblk = DMODEL / 32, kb = r / nblk, nb = r % nblk; p0_transpose_item(args.in[11], DMODEL, DMODEL, Wout_t, 64 * kb, 32 * nb, 32 * nb, nullptr, scr, F.lane); continue; } r -= I_OUT;
            if (r < 2 * I_G) { const int up = r >= I_G; if (up) r -= I_G; const int nblk = DFF / 32, kb = r / nblk, nb = r % nblk, n0 = 32 * nb;
                p0_transpose_item(args.in[up ? 14 : 13], DMODEL, DFF, Wgu_t, 64 * kb, n0, 256 * (n0 >> 7) + 128 * up + (n0 & 127), args.in[12], scr, F.lane); continue; } r -= 2 * I_G;
            { const int nblk = DMODEL / 32, kb = r / nblk, nb = r % nblk; p0_transpose_item(args.in[15], DFF, DMODEL, Wd_t, 64 * kb, 32 * nb, 32 * nb, nullptr, scr, F.lane); }
        }
    } else {
        if (part == 0) {
            float* rinv = (float*)(ws + WS_RINV); const float* x = args.in[0];
            const bool loc = F.G == 256; const int st = loc ? 1024 : 4 * NGW, mend = loc ? 4096 * (F.vcu >> 5) + 4096 : MTOK;
            for (int m = loc ? 4096 * (F.vcu >> 5) + ((F.vcu & 31) * NWAVES + F.wave) * 4 : 4 * gw; m < mend; m += 2 * st) { f32x4 va[4][4], vb[4][4]; const int m2 = m + st; const bool h2 = m2 < mend;
                rms_rows_load<4>(va, F.lane, x + (size_t)m * DMODEL); if (h2) rms_rows_load<4>(vb, F.lane, x + (size_t)m2 * DMODEL);
                rms_rows_finish<4>(va, F.lane, XN + (size_t)m * DMODEL, rinv, m);
                if (h2) rms_rows_finish<4>(vb, F.lane, XN + (size_t)m2 * DMODEL, rinv, m2); } }
    }
    }
}

__global__ void __launch_bounds__(NWAVES * 64, 2) skel_fwd(Args args) {
    extern __shared__ __attribute__((aligned(16))) unsigned char lds[];
    Frame F;
    F.lds = (LAS unsigned char*)lds;
    F.MISC = (volatile LAS unsigned*)(F.lds + MISC_OFF);
    F.tid = threadIdx.x; F.lane = F.tid & 63; F.wave = __builtin_amdgcn_readfirstlane(F.tid >> 6);
    F.G = gridDim.x; { const int bx = blockIdx.x; F.vcu = (F.G % 8 == 0) ? (bx % 8) * (F.G / 8) + bx / 8 : bx; }
    unsigned char* ws = args.ws;
    F.ctl = (gu32*)(ws + WS_CTL);
    for (int u = F.tid; u < (LDS_BYTES - LDSCTL_OFF) / 4; u += NWAVES * 64) ((LAS unsigned*)(F.lds + LDSCTL_OFF))[u] = 0u;
    __syncthreads();
    XcdBarrier bar = xcd_barrier_post((unsigned*)(F.ctl + CW_BAR) + args.li * XCD_BAR_WORDS, F.MISC + 8);
    const int lo = args.ph_lo, hi = args.ph_hi;
#define IN(k) (lo <= (k) && (k) < hi)
#define BOTH(k) (IN(k) && IN((k) + 1))
    bf16* Win_t = (bf16*)(ws + WS_WIN); bf16* Wout_t = (bf16*)(ws + WS_WOUT); bf16* Wgu_t = (bf16*)(ws + WS_WGU); bf16* Wd_t = (bf16*)(ws + WS_WD);
    bf16* PROJ = (bf16*)(ws + WS_PROJ); bf16* XN = (bf16*)(ws + WS_XN); bf16* MIX = (bf16*)(ws + WS_MIX); bf16* XH = (bf16*)(ws + WS_XH); bf16* ACT = (bf16*)(ws + WS_ACT); float* SSQ = (float*)(ws + WS_SSQ);

    if (IN(0)) { for (int rep = 0; rep < MK_REP_P0; ++rep) p0_prologue(F, args, 0); if (BOTH(0)) { xcd_barrier(bar); if (MK_PROBE_XBAR2) xcd_barrier(bar); } }
    if (IN(1)) {
        pg8::Gemm g{XN, Win_t, MTOK, INC, DMODEL}; pg8::StaticOrder S; S.init(MTOK, INC, F.G, (int)blockIdx.x, MK_REP_P1);
        pg8::EpiInProj E{PROJ, args.in[3], args.in[4]};
        pg8::gemm_phase<pg8::EpiInProj, pg8::StaticOrder, PG8_ALIGN, PG8_SP2>(F.lds + RING_OFF, g, S, E);
        if (BOTH(1)) { xcd_barrier(bar); if (MK_PROBE_XBAR2) xcd_barrier(bar); }
    }
    if (IN(2)) {
        const bf16* DQ = PROJ; const size_t TS = (size_t)MTOK * 512;
        att::lds_ptr ring = (att::lds_ptr)(F.lds + RING_OFF); att::lds_ptr wsfb = (att::lds_ptr)(F.lds + WSF_OFF);
        LAS float* tab = (LAS float*)(F.lds + TAB_OFF);
        for (int i = F.tid; i < 1024; i += NWAVES * 64) { const int h = i >> 8, rel = (i & 255) - 191; tab[i] = (i & 255) == 255 ? args.in[16][15 * 4 + h] * att::LOG2E : (args.in[16][att::t5_bucket(rel) * 4 + h] - args.in[16][15 * 4 + h]) * att::LOG2E; }
        const float lam = __expf(wave_sum(args.in[5][F.lane] * args.in[6][F.lane])) - __expf(wave_sum(args.in[7][F.lane] * args.in[8][F.lane])) + 0.2f;
        const float sbound = 1.02f * 64.0f * pg8::C2_ * wave_max(fabsf(args.in[3][F.lane])) * wave_max(fabsf(args.in[4][F.lane]));
        { const f32x4 rb4 = *(const f32x4*)(args.in[16] + (F.lane & 31) * 4);
          const float m0 = wave_max(rb4.x), m1 = wave_max(rb4.y), m2 = wave_max(rb4.z), m3 = wave_max(rb4.w);
          if (F.tid == 0) { F.MISC[20] = __float_as_uint(sbound + att::LOG2E * m0); F.MISC[21] = __float_as_uint(sbound + att::LOG2E * m1); F.MISC[22] = __float_as_uint(sbound + att::LOG2E * m2); F.MISC[23] = __float_as_uint(sbound + att::LOG2E * m3); } }
        __syncthreads();
        for (int rep = 0; rep < MK_REP_DIFF; ++rep)
        if (args.flags & 1) { att::bf16x8 qfr[4];
            const int nun = 2 * ((512 - F.vcu + F.G - 1) / F.G);
#define DPAIR(j) (F.G == 256 ? 64 * (F.vcu >> 5) + (F.vcu & 31) + 32 * (j) : F.vcu + (j) * F.G)
            for (int k = 0; k < nun; ++k) { const int pr = DPAIR(k >> 1), bh = pr >> 4, s = pr & 15, h = bh & 3, u = (k & 1) ? s : 31 - s;
                const int k2 = k + 1, pr2 = DPAIR(k2 >> 1), bh2 = pr2 >> 4, s2 = pr2 & 15, u2 = (k2 & 1) ? s2 : 31 - s2;
                const float mbound = __uint_as_float(F.MISC[20 + h]);
                att::diff_unit<6>(bh >> 2, h, u, DQ, DQ + TS, DQ + 2 * TS, MIX, (att::lds_cptr)(tab + h * 256), tab[h * 256 + 255], mbound, lam, args.in[9], ring, wsfb, qfr, k > 0, bh2 >> 2, bh2 & 3, k2 < nun ? u2 : -1); } }
        for (int rep = 0; rep < MK_REP_SB; ++rep)
        if (args.flags & 2) for (int grp = F.vcu; grp < 256; grp += F.G) {
            if (F.tid == 0) F.MISC[16] = 0u;
            __syncthreads();
            for (;;) { unsigned qi = 0u; if (F.lane == 0) qi = __hip_atomic_fetch_add((LAS unsigned*)(F.MISC + 16), 1u, __ATOMIC_RELAXED, __HIP_MEMORY_SCOPE_WORKGROUP);
                qi = (unsigned)__builtin_amdgcn_readfirstlane((int)qi); if (qi >= 32u) break;
                const int item = grp * 32 + (int)qi, bh = item >> 7, rb = item & 127;
                att::sb_item(bh >> 3, bh & 7, rb, DQ + 3 * TS, DQ + 4 * TS, DQ + 5 * TS, MIX, args.in[10], ring + F.wave * 16384, wsfb + F.wave * 512); }
            if (grp + F.G < 256) __syncthreads(); }
        p0_prologue(F, args, 1);
        if (BOTH(2)) { xcd_barrier(bar); if (MK_PROBE_XBAR2) xcd_barrier(bar); }
    }
    if (IN(3)) {
        pg8::Gemm g{MIX, Wout_t, MTOK, DMODEL, DMODEL}; pg8::StaticOrder S; S.init(MTOK, DMODEL, F.G, (int)blockIdx.x, MK_REP_P3);
        pg8::EpiOutProj E{XN, (const float*)(ws + WS_RINV), XH, SSQ};
        pg8::gemm_phase<pg8::EpiOutProj, pg8::StaticOrder, PG8_ALIGN, PG8_SP2>(F.lds + RING_OFF, g, S, E);
        if (BOTH(3)) { xcd_barrier(bar); if (MK_PROBE_XBAR2) xcd_barrier(bar); }
    }
    if (IN(4)) {
        pg8::Gemm g{XH, Wgu_t, MTOK, NGU, DMODEL}; pg8::StaticOrder S; S.init(MTOK, NGU, F.G, (int)blockIdx.x, MK_REP_P4);
        int pml[4] = {-1, -1, -1, -1};
        { pg8::Unit uu; int n = 0; for (int i = 0; S.next(i, uu) && uu.rep == 0; ++i) { if (uu.pm != pml[0] && uu.pm != pml[1] && uu.pm != pml[2] && uu.pm != pml[3] && n < 4) { if (n == 0) pml[0] = uu.pm; else if (n == 1) pml[1] = uu.pm; else if (n == 2) pml[2] = uu.pm; else pml[3] = uu.pm; ++n; } } }
        LAS float* rsl = (LAS float*)(F.lds + RSTD_OFF);
        pg8::EpiSwiGLU E{SSQ, ACT, (const LAS float*)rsl, pml[0], pml[1], pml[2], pml[3]};
        pg8::gemm_phase<pg8::EpiSwiGLU, pg8::StaticOrder, PG8_ALIGN, PG8_SP2>(F.lds + RING_OFF, g, S, E);
        if (BOTH(4)) { xcd_barrier(bar); if (MK_PROBE_XBAR2) xcd_barrier(bar); }
    }
    if (IN(5)) {
        pg8::Gemm g{ACT, Wd_t, MTOK, DMODEL, DFF}; pg8::StaticOrder S; S.init(MTOK, DMODEL, F.G, (int)blockIdx.x, MK_REP_P5, MK_WGM_P5);
        int pml[4] = {-1, -1, -1, -1};
        { pg8::Unit uu; int n = 0; for (int i = 0; S.next(i, uu) && uu.rep == 0; ++i) { if (uu.pm != pml[0] && uu.pm != pml[1] && uu.pm != pml[2] && uu.pm != pml[3] && n < 4) { if (n == 0) pml[0] = uu.pm; else if (n == 1) pml[1] = uu.pm; else if (n == 2) pml[2] = uu.pm; else pml[3] = uu.pm; ++n; } } }
        LAS float* rsl = (LAS float*)(F.lds + RSTD_OFF);
        pg8::EpiDown E{XH, args.out, SSQ, (const LAS float*)rsl, pml[0], pml[1], pml[2], pml[3]};
        pg8::gemm_phase<pg8::EpiDown, pg8::StaticOrder, PG8_ALIGN, PG8_SP2>(F.lds + RING_OFF, g, S, E);
    }
#undef IN
#undef BOTH
}
extern "C" void kernel_launch(void* const* d_in, const int* in_sizes, int n_in, void* d_out, int out_size, void* d_ws, size_t ws_size, hipStream_t stream) {
    static int grid = 0;
    if (grid == 0) {
        if (n_in != 17 || in_sizes[0] != MTOK * DMODEL || out_size != MTOK * DMODEL || ws_size < WS_END) { fprintf(stderr, "kernel_launch: unexpected problem shape; nothing launched\n"); grid = -1; return; }
        int dev = 0, cus = 0, per_cu = 0;
        if (hipGetDevice(&dev) != hipSuccess || hipDeviceGetAttribute(&cus, hipDeviceAttributeMultiprocessorCount, dev) != hipSuccess) { grid = -1; return; }
        if (hipFuncSetAttribute((const void*)skel_fwd, hipFuncAttributeMaxDynamicSharedMemorySize, LDS_BYTES) != hipSuccess) { fprintf(stderr, "kernel_launch: hipFuncSetAttribute failed\n"); grid = -1; return; }
        if (hipOccupancyMaxActiveBlocksPerMultiprocessor(&per_cu, (const void*)skel_fwd, NWAVES * 64, LDS_BYTES) != hipSuccess || per_cu < 1) { fprintf(stderr, "kernel_launch: occupancy query reports %d\n", per_cu); per_cu = 1; }
        (void)hipGetLastError();
        grid = cus;
    }
    if (grid < 0) return;
    if (hipMemsetAsync((char*)d_ws + WS_CTL, 0, CTL_ZERO_BYTES, stream) != hipSuccess) return;
    Args a{};
    for (int i = 0; i < 17; ++i) a.in[i] = (const float*)d_in[i];
    a.out = (float*)d_out; a.ws = (unsigned char*)d_ws;
    a.ph_lo = 0; a.ph_hi = 6; a.li = 0; a.flags = 3;
    hipLaunchKernelGGL(skel_fwd, dim3(grid), dim3(NWAVES * 64), LDS_BYTES, stream, a);
}
```

```cpp
#ifndef MK_REP_P0
#define MK_REP_P0 1
#endif
#ifndef MK_REP_P1
#define MK_REP_P1 1
#endif
#ifndef MK_REP_DIFF
#define MK_REP_DIFF 1
#endif
#ifndef MK_REP_SB
#define MK_REP_SB 1
#endif
#ifndef MK_REP_P3
#define MK_REP_P3 1
#endif
#ifndef MK_REP_P4
#define MK_REP_P4 1
#endif
#ifndef MK_REP_P5
#define MK_REP_P5 1
#endif
#ifndef MK_DIFF_PRIO_STATIC
#define MK_DIFF_PRIO_STATIC 1
#endif
#ifndef MK_DIFF_PRIO_B
#define MK_DIFF_PRIO_B 0
#endif
#ifndef MK_LOCAL_SEAMS
#define MK_LOCAL_SEAMS 1
#endif
#ifndef MK_PROBE_BAR2
#define MK_PROBE_BAR2 0
#endif
#ifndef MK_PROBE_DMA2
#define MK_PROBE_DMA2 0
#endif
#ifndef MK_PROBE_XBAR2
#define MK_PROBE_XBAR2 0
#endif
#ifndef MK_WGM_P5
#define MK_WGM_P5 8
#endif
#ifndef MK_PROBE_SBVALU
#define MK_PROBE_SBVALU 0
#endif
#ifndef MK_PROBE_DFVALU
#define MK_PROBE_DFVALU 0
#endif
#ifndef MK_PROBE_SBX2
#define MK_PROBE_SBX2 0
#endif
#ifndef MK_PROBE_CLOCK
#define MK_PROBE_CLOCK 0
#endif
#ifndef MK_NT_P5
#define MK_NT_P5 0
#endif
#ifndef MK_REV_P5
#define MK_REV_P5 0
#endif
#ifndef MK_FAST_BOUND
#define MK_FAST_BOUND 60.f
#endif
#ifndef MK_PROBE_CLOCK4
#define MK_PROBE_CLOCK4 0
#endif
#ifndef MK_XTOUCH
#define MK_XTOUCH 0
#endif
#ifndef MK_PROBE_IDLE
#define MK_PROBE_IDLE 0
#endif
#include <hip/hip_runtime.h>
#include <cstdio>
#include <cstdint>
namespace pg8 {
#define PG8_LAS __attribute__((address_space(3)))
typedef unsigned short bf16_t;
typedef short bf16x8 __attribute__((ext_vector_type(8)));
typedef float f32x4 __attribute__((ext_vector_type(4)));
typedef unsigned u32x4 __attribute__((ext_vector_type(4)));
constexpr int BM = 256, BK = 64, HALF = 128, HTB = HALF * BK * 2  , STAGE_BYTES = 8 * HTB, NXCD = 8, WGM = 8;

__host__ __device__ __forceinline__ int lds_byte(int r, int c) { const int st = (r >> 4) * 2 + (c >> 5), rr = r & 15, cc = c & 31, ob = rr * 64 + cc * 2; return st * 1024 + (ob ^ (((ob >> 9) & 1) << 5)); }
__host__ __device__ __forceinline__ void stage_rc(int b, int& R, int& C) { const int st = b / 1024, sb = b % 1024, swz = sb ^ (((sb >> 9) & 1) << 5); R = (st >> 1) * 16 + swz / 64; C = (st & 1) * 32 + (swz % 64) / 2; }
__host__ __device__ __forceinline__ int perm32(int rho) { const int n = rho >> 4, i = rho & 15; return 8 * (i >> 2) + 4 * n + (i & 3); }

struct Unit { int pm, pn, rep; };
struct Gemm { const bf16_t* A; const bf16_t* Bt; int M, N, K; };

struct StaticOrder {
    int nM, nN, nwg, G, c, reps, wgm, rev;
    __host__ __device__ void init(int M, int N, int G_, int c_, int reps_ = 1, int wgm_ = WGM, int rev_ = 0) { nM = M / BM; nN = N / BM; nwg = nM * nN; G = G_; c = c_; reps = reps_; wgm = wgm_; rev = rev_; }
    __host__ __device__ bool next(int i, Unit& u) const {
        const long L = (long)i * G + c; if (L >= (long)nwg * reps) return false;
        int wgid = (int)(L % nwg); u.rep = (int)(L / nwg); { const int q = nwg / NXCD, r = nwg % NXCD, xcd = wgid % NXCD, off0 = wgid / NXCD, off = rev ? q + (xcd < r ? 1 : 0) - 1 - off0 : off0; wgid = (xcd < r ? xcd * (q + 1) : r * (q + 1) + (xcd - r) * q) + off; }
        const int nig = wgm * nN, gid = wgid / nig, fm = gid * wgm, gsz = (nM - fm) < wgm ? (nM - fm) : wgm;
        u.pm = fm + ((wgid % nig) % gsz); u.pn = (wgid % nig) / gsz; return true;
    }
    __device__ __forceinline__ void a_ready(const Unit&) const {}
    __device__ __forceinline__ void done(const Unit&) const {}
};

__device__ __forceinline__ unsigned cvt_pk_bf16(float lo, float hi) { unsigned r; asm volatile("v_cvt_pk_bf16_f32 %0, %1, %2" : "=v"(r) : "v"(lo), "v"(hi)); return r; }
typedef float f32x2 __attribute__((ext_vector_type(2)));
constexpr int MTOK_ = 32768;
constexpr float C2_ = 0.125f * 1.4426950408889634f;
constexpr float EPS_ = 1e-6f;
typedef unsigned u32x2 __attribute__((ext_vector_type(2)));
typedef float f32x2_t __attribute__((ext_vector_type(2)));
__device__ __forceinline__ float rows4_sum(float s) { auto a = __builtin_amdgcn_permlane16_swap(__float_as_uint(s), __float_as_uint(s), false, false); s = __uint_as_float(a[0]) + __uint_as_float(a[1]);
    auto c = __builtin_amdgcn_permlane32_swap(__float_as_uint(s), __float_as_uint(s), false, false); return __uint_as_float(c[0]) + __uint_as_float(c[1]); }
__host__ __device__ __forceinline__ int rinv_index(int r) { return ((((r >> 8) * 2 + ((r >> 6) & 1)) * 16 + (r & 15)) << 3) + ((r >> 7) & 1) * 4 + ((r >> 4) & 3); }
__device__ __forceinline__ void swap16(unsigned& a, unsigned& b) { auto r = __builtin_amdgcn_permlane16_swap(a, b, false, false); a = r[0]; b = r[1]; }
__device__ __forceinline__ int wide_coff(int fq) { return 4 * fq + ((fq & 1) ? 12 : 0); }
__device__ __forceinline__ void wide_load(const bf16_t* p, u32x2& v0, u32x2& v1) { const u32x4 L = *(const u32x4*)p; unsigned a = L.x, b = L.y, c = L.z, d = L.w; swap16(a, c); swap16(b, d); v0.x = a; v0.y = b; v1.x = c; v1.y = d; }
__device__ __forceinline__ void wide_store(bf16_t* p, u32x2 w0, u32x2 w1) { unsigned a = w0.x, b = w0.y, c = w1.x, d = w1.y; swap16(a, c); swap16(b, d); u32x4 S; S.x = a; S.y = b; S.z = c; S.w = d; *(u32x4*)p = S; }
__device__ __forceinline__ size_t tile_image_off(int region, int row, int col) {
    if (region == 0 || region == 3) return (size_t)row * 512 + col;
    const int b = row >> 12, t = (row >> 6) & 63, rr = row & 63;
    if (region == 1) { const int h = col >> 7, ch = col & 127; return ((size_t)((b * 4 + h) * 64 + t) << 13) + (ch >> 3) * 512 + rr * 8; }
    if (region == 2) { const int h = col >> 7, ch = col & 127; return ((size_t)((b * 4 + h) * 64 + t) << 13) + (ch >> 5) * 2048 + rr * 32 + (ch & 31); }
    if (region == 4) { const int h = col >> 6, ch = col & 63;  return ((size_t)((b * 8 + h) * 64 + t) << 12) + (ch >> 3) * 512 + rr * 8; }
    { const int h = col >> 6, ch = col & 63;                   return ((size_t)((b * 8 + h) * 64 + t) << 12) + (ch >> 5) * 2048 + rr * 32 + (ch & 31); }
}
struct EpiInProj {
    static constexpr bool PERM = true, AFTER_DRAIN = false, HOOK = false;
    bf16_t* proj; const float* qnw; const float* knw;
    __device__ __forceinline__ void operator()(const f32x4 (&acc)[2][2][4][2], const Unit& u, int wr, int wc, int fr, int fq) const {
        const int region = u.pn >> 1, cin0 = (u.pn & 1) * 256 + 64 * wc + 8 * fq;
        bf16_t* base = proj + (size_t)region * MTOK_ * 512;
        const int row0 = u.pm * BM + wr * 64 + fr;
        f32x4 wv[2][2]; float post = 1.f;
        const bool nrm = region < 2;
        { const float* nw = region == 0 ? qnw : knw;
#pragma unroll
          for (int bj = 0; bj < 2; ++bj)
#pragma unroll
            for (int n = 0; n < 2; ++n) wv[bj][n] = nrm ? *(const f32x4*)(nw + 32 * bj + 8 * fq + 4 * n) : (f32x4){1.f, 1.f, 1.f, 1.f}; }
        if (region == 0 || region == 3) post = C2_;
#pragma unroll
        for (int ai = 0; ai < 2; ++ai)
#pragma unroll
            for (int m = 0; m < 4; ++m) {
                float rs = post;
                if (nrm) { f32x2_t s2 = {0.f, 0.f};
#pragma unroll
                    for (int bj = 0; bj < 2; ++bj)
#pragma unroll
                        for (int n = 0; n < 2; ++n) { const f32x4 v = acc[ai][bj][m][n]; const f32x2_t lo = {v[0], v[1]}, hi = {v[2], v[3]}; s2 = lo * lo + s2; s2 = hi * hi + s2; }
                    const float s = rows4_sum(s2.x + s2.y);
                    rs = post * __builtin_amdgcn_rsqf(s * (1.0f / 64.0f) + EPS_); }
                const int row = row0 + ai * HALF + m * 16;
#pragma unroll
                for (int bj = 0; bj < 2; ++bj) { f32x4 v0 = acc[ai][bj][m][0], v1 = acc[ai][bj][m][1];
                    if (nrm) { v0 = v0 * wv[bj][0] * rs; v1 = v1 * wv[bj][1] * rs; } else if (region == 3) { v0 = v0 * C2_; v1 = v1 * C2_; }
                    u32x4 w; w.x = cvt_pk_bf16(v0[0], v0[1]); w.y = cvt_pk_bf16(v0[2], v0[3]); w.z = cvt_pk_bf16(v1[0], v1[1]); w.w = cvt_pk_bf16(v1[2], v1[3]);
                    *(u32x4*)(base + tile_image_off(region, row, cin0 + 32 * bj)) = w; }
            }
    }
};
struct EpiOutProj {
    static constexpr bool PERM = false, AFTER_DRAIN = false, HOOK = false;
    const bf16_t* xn; const float* rinv; bf16_t* xh; float* ssq;
    __device__ __forceinline__ void operator()(const f32x4 (&acc)[2][2][4][2], const Unit& u, int wr, int wc, int fr, int fq) const {
        const int row0 = u.pm * BM + wr * 64 + fr, colw = u.pn * BM + wc * 32 + wide_coff(fq);
        u32x2 xv[2][4][2][2]; float ri[2][4], ss[2][4];
        { const f32x4* rp = (const f32x4*)(rinv + rinv_index(u.pm * BM + wr * 64 + fr)); const f32x4 r0 = rp[0], r1 = rp[1];
          ri[0][0] = r0[0]; ri[0][1] = r0[1]; ri[0][2] = r0[2]; ri[0][3] = r0[3]; ri[1][0] = r1[0]; ri[1][1] = r1[1]; ri[1][2] = r1[2]; ri[1][3] = r1[3]; }
#pragma unroll
        for (int ai = 0; ai < 2; ++ai)
#pragma unroll
            for (int m = 0; m < 4; ++m) {
#pragma unroll
                for (int bj = 0; bj < 2; ++bj) wide_load(xn + (size_t)(row0 + ai * HALF + m * 16) * 1024 + colw + bj * HALF, xv[ai][m][bj][0], xv[ai][m][bj][1]); }
#pragma unroll
        for (int ai = 0; ai < 2; ++ai)
#pragma unroll
            for (int m = 0; m < 4; ++m) { const int row = row0 + ai * HALF + m * 16; const size_t off = (size_t)row * 1024 + colw; f32x2_t s2 = {0.f, 0.f}; const float rr = ri[ai][m];
#pragma unroll
                for (int bj = 0; bj < 2; ++bj) { u32x2 w[2];
#pragma unroll
                    for (int n = 0; n < 2; ++n) { const u32x2 hb = xv[ai][m][bj][n];
                        const f32x4 r = (f32x4){__uint_as_float(hb.x << 16), __uint_as_float(hb.x & 0xffff0000u), __uint_as_float(hb.y << 16), __uint_as_float(hb.y & 0xffff0000u)} * rr + acc[ai][bj][m][n];
                        { const f32x2_t lo = {r[0], r[1]}, hi = {r[2], r[3]}; s2 = lo * lo + s2; s2 = hi * hi + s2; }
                        w[n].x = cvt_pk_bf16(r[0], r[1]); w[n].y = cvt_pk_bf16(r[2], r[3]); }
                    wide_store(xh + off + bj * HALF, w[0], w[1]); }
                ss[ai][m] = rows4_sum(s2.x + s2.y); }
#pragma unroll
        for (int ai = 0; ai < 2; ++ai) { const float v = fq == 0 ? ss[ai][0] : fq == 1 ? ss[ai][1] : fq == 2 ? ss[ai][2] : ss[ai][3];
            ssq[(size_t)(row0 + ai * HALF + fq * 16) * 16 + u.pn * 4 + wc] = v; }
    }
};
struct EpiSwiGLU {
    static constexpr bool PERM = true, AFTER_DRAIN = false, HOOK = true;
    const float* ssq; bf16_t* act; const PG8_LAS float* rs_lds; int pml0, pml1, pml2, pml3;
    template <bool SQUARED> __device__ __forceinline__ void build_cache(int tid) const {
        PG8_LAS float* rsl = (PG8_LAS float*)rs_lds;
        for (int i = tid; i < 4 * 256; i += 512) { const int sl = i >> 8, pm = sl == 0 ? pml0 : sl == 1 ? pml1 : sl == 2 ? pml2 : pml3;
            if (pm >= 0) { const f32x4* pp = (const f32x4*)(ssq + (size_t)(pm * 256 + (i & 255)) * 16); const f32x4 a = pp[0], b2 = pp[1], c2 = pp[2], d2 = pp[3];
                const float s = ((a.x + a.y) + (a.z + a.w)) + ((b2.x + b2.y) + (b2.z + b2.w)) + ((c2.x + c2.y) + (c2.z + c2.w)) + ((d2.x + d2.y) + (d2.z + d2.w));
                const float v = s * (1.0f / 1024.0f) + EPS_; rsl[i] = SQUARED ? 1.0f / v : 1.0f / sqrtf(v); } }
        __syncthreads();
    }
    __device__ __forceinline__ void hook(int tid) const { build_cache<false>(tid); }
    __device__ __forceinline__ void operator()(const f32x4 (&acc)[2][2][4][2], const Unit& u, int wr, int wc, int fr, int fq) const {
        const int row0 = u.pm * BM + wr * 64 + fr, col0 = u.pn * HALF + wc * 32 + 8 * fq;
        const int slot = u.pm == pml0 ? 0 : u.pm == pml1 ? 1 : u.pm == pml2 ? 2 : u.pm == pml3 ? 3 : -1;
#pragma unroll
        for (int ai = 0; ai < 2; ++ai)
#pragma unroll
            for (int m = 0; m < 4; ++m) { const int row = row0 + ai * HALF + m * 16;
                float rstd;
                if (slot >= 0) rstd = rs_lds[slot * BM + wr * 64 + fr + ai * HALF + m * 16];
                else { const f32x4 p = *(const f32x4*)(ssq + (size_t)row * 16 + 4 * fq); float s = (p[0] + p[1]) + (p[2] + p[3]);
                    s += __shfl_xor(s, 16); s += __shfl_xor(s, 32);
                    rstd = 1.0f / sqrtf(s * (1.0f / 1024.0f) + EPS_); }
                float a[8]; const float kk = -1.4426950408889634f * rstd;
#pragma unroll
                for (int n = 0; n < 2; ++n)
#pragma unroll
                    for (int i = 0; i < 4; i += 2) {
                        const f32x2_t g = {acc[ai][0][m][n][i], acc[ai][0][m][n][i + 1]}, up = {acc[ai][1][m][n][i], acc[ai][1][m][n][i + 1]};
                        const f32x2_t z = g * kk; f32x2_t d = {__builtin_amdgcn_exp2f(z.x), __builtin_amdgcn_exp2f(z.y)}; d = d + 1.0f;
                        const f32x2_t r = {__builtin_amdgcn_rcpf(d.x), __builtin_amdgcn_rcpf(d.y)}, o2 = (g * up) * r;
                        a[4 * n + i] = o2.x; a[4 * n + i + 1] = o2.y; }
                u32x4 w; w.x = cvt_pk_bf16(a[0], a[1]); w.y = cvt_pk_bf16(a[2], a[3]); w.z = cvt_pk_bf16(a[4], a[5]); w.w = cvt_pk_bf16(a[6], a[7]);
                *(u32x4*)(act + (size_t)row * 2816 + col0) = w; }
    }
};
struct EpiDown {
    static constexpr bool PERM = false, AFTER_DRAIN = false, HOOK = true;
    const bf16_t* xh; float* out; const float* ssq; const PG8_LAS float* rs_lds; int pml0, pml1, pml2, pml3;
    template <bool SQUARED> __device__ __forceinline__ void build_cache(int tid) const {
        PG8_LAS float* rsl = (PG8_LAS float*)rs_lds;
        for (int i = tid; i < 4 * 256; i += 512) { const int sl = i >> 8, pm = sl == 0 ? pml0 : sl == 1 ? pml1 : sl == 2 ? pml2 : pml3;
            if (pm >= 0) { const f32x4* pp = (const f32x4*)(ssq + (size_t)(pm * 256 + (i & 255)) * 16); const f32x4 a = pp[0], b2 = pp[1], c2 = pp[2], d2 = pp[3];
                const float s = ((a.x + a.y) + (a.z + a.w)) + ((b2.x + b2.y) + (b2.z + b2.w)) + ((c2.x + c2.y) + (c2.z + c2.w)) + ((d2.x + d2.y) + (d2.z + d2.w));
                const float v = s * (1.0f / 1024.0f) + EPS_; rsl[i] = SQUARED ? 1.0f / v : 1.0f / sqrtf(v); } }
        __syncthreads();
    }
    __device__ __forceinline__ void hook(int tid) const { build_cache<true>(tid); }
    __device__ __forceinline__ void operator()(const f32x4 (&acc)[2][2][4][2], const Unit& u, int wr, int wc, int fr, int fq) const {
        const int row0 = u.pm * BM + wr * 64 + fr, col0 = u.pn * BM + wc * 32 + 4 * fq;
        u32x2 hv[2][4][2][2]; float rs2[2][4];
        const int slot = u.pm == pml0 ? 0 : u.pm == pml1 ? 1 : u.pm == pml2 ? 2 : u.pm == pml3 ? 3 : -1;
#pragma unroll
        for (int ai = 0; ai < 2; ++ai)
#pragma unroll
            for (int m = 0; m < 4; ++m)
#pragma unroll
                for (int bj = 0; bj < 2; ++bj) wide_load(xh + (size_t)(row0 + ai * HALF + m * 16) * 1024 + (col0 - 4 * fq + wide_coff(fq)) + bj * HALF, hv[ai][m][bj][0], hv[ai][m][bj][1]);
#pragma unroll
        for (int ai = 0; ai < 2; ++ai)
#pragma unroll
            for (int m = 0; m < 4; ++m) {
                if (slot >= 0) rs2[ai][m] = rs_lds[slot * BM + wr * 64 + fr + ai * HALF + m * 16];
                else { const f32x4 p = *(const f32x4*)(ssq + (size_t)(row0 + ai * HALF + m * 16) * 16 + 4 * fq); float s = (p[0] + p[1]) + (p[2] + p[3]);
                    s += __shfl_xor(s, 16); s += __shfl_xor(s, 32); rs2[ai][m] = 1.0f / (s * (1.0f / 1024.0f) + EPS_); } }
#pragma unroll
        for (int ai = 0; ai < 2; ++ai)
#pragma unroll
            for (int m = 0; m < 4; ++m) { const size_t off = (size_t)(row0 + ai * HALF + m * 16) * 1024 + col0; const float r2 = rs2[ai][m];
#pragma unroll
                for (int bj = 0; bj < 2; ++bj)
#pragma unroll
                    for (int n = 0; n < 2; ++n) { const size_t o = off + bj * HALF + n * 16; const u32x2 hb = hv[ai][m][bj][n];
                        const f32x4 h1 = (f32x4){__uint_as_float(hb.x << 16), __uint_as_float(hb.x & 0xffff0000u), __uint_as_float(hb.y << 16), __uint_as_float(hb.y & 0xffff0000u)};
                        *(f32x4*)(out + o) = h1 + acc[ai][bj][m][n] * r2; } }
    }
};

template <class Epi, class Sched, bool ALIGN_EPI = false, bool SP2 = false>
__device__ __forceinline__ void gemm_phase(PG8_LAS unsigned char* lds, const Gemm g, const Sched& S, const Epi& E) {
    const int tid = threadIdx.x, wid = __builtin_amdgcn_readfirstlane(tid >> 6), lane = tid & 63, wr = wid >> 2, wc = wid & 3, fr = lane & 15, fq = lane >> 4;
    const int K = g.K, nt = K / BK;
    unsigned voffA[2], voffB[2];
#pragma unroll
    for (int i = 0; i < 2; ++i) { int R, C; stage_rc(tid * 16 + i * 8192, R, C); const int Rb = Epi::PERM ? ((R & ~31) + perm32(R & 31)) : R;
        voffA[i] = (unsigned)(R * K + C) * 2u; voffB[i] = (unsigned)(Rb * K + C) * 2u; }
    const size_t kstep = (size_t)(BK * 2);
    const size_t hstep = (size_t)HALF * K * 2;
    const size_t tstep = 2 * hstep;
    const unsigned ldsw = (unsigned)wid * 1024u;
    const int aoff = lds_byte(wr * 64 + fr, fq * 8), boff = lds_byte(wc * 32 + fr, fq * 8);
#define PG8_SA(b, h) (((b) * 2 + (h)) * HTB)
#define PG8_SB(b, h) ((4 + (b) * 2 + (h)) * HTB)
#define PG8_STAGE(bufoff, gbase, voff) do { _Pragma("unroll") for (int _i = 0; _i < 2; ++_i) \
        __builtin_amdgcn_global_load_lds((const unsigned*)((const char*)(gbase) + (voff)[_i]), (PG8_LAS unsigned*)(lds + (bufoff) + ldsw + _i * 8192), 16, 0, 0); } while (0)
#define PG8_LDA(dst, b, h) do { _Pragma("unroll") for (int m = 0; m < 4; ++m) _Pragma("unroll") for (int k = 0; k < 2; ++k) dst[m][k] = *(const PG8_LAS bf16x8*)(lds + PG8_SA(b, h) + aoff + m * 2048 + k * 1024); } while (0)
#define PG8_LDB(dst, b, h) do { _Pragma("unroll") for (int n = 0; n < 2; ++n) _Pragma("unroll") for (int k = 0; k < 2; ++k) dst[n][k] = *(const PG8_LAS bf16x8*)(lds + PG8_SB(b, h) + boff + n * 2048 + k * 1024); } while (0)
#define PG8_MMA(ai, bj, At, Bt) do { __builtin_amdgcn_s_setprio(1); _Pragma("unroll") for (int m = 0; m < 4; ++m) _Pragma("unroll") for (int n = 0; n < 2; ++n) _Pragma("unroll") for (int k = 0; k < 2; ++k) \
        acc[ai][bj][m][n] = __builtin_amdgcn_mfma_f32_16x16x32_bf16(Bt[n][k], At[m][k], acc[ai][bj][m][n], 0, 0, 0); __builtin_amdgcn_s_setprio(0); } while (0)
#define PG8_WAIT_V(n) asm volatile("s_waitcnt vmcnt(" #n ")" ::: "memory")
#define PG8_WAIT_L(n) asm volatile("s_waitcnt lgkmcnt(" #n ")" ::: "memory")
#define PG8_BAR __builtin_amdgcn_s_barrier()
#define PG8_SCHED __builtin_amdgcn_sched_barrier(0)
    Unit cur, nxt; int ui = 0;
    if (!S.next(0, cur)) return;
    f32x4 acc[2][2][4][2];
#pragma unroll
    for (int a = 0; a < 2; ++a)
#pragma unroll
        for (int b = 0; b < 2; ++b)
#pragma unroll
            for (int m = 0; m < 4; ++m)
#pragma unroll
                for (int n = 0; n < 2; ++n) acc[a][b][m][n] = (f32x4){0.f, 0.f, 0.f, 0.f};
    bf16x8 At[4][2], B0[2][2], B1[2][2];
    const char* cA = (const char*)g.A + (size_t)cur.pm * tstep; const char* cB = (const char*)g.Bt + (size_t)cur.pn * tstep;
    S.a_ready(cur);
    if constexpr (SP2) {
        PG8_STAGE(PG8_SB(0, 0), cB, voffB); PG8_STAGE(PG8_SB(0, 1), cB + hstep, voffB); PG8_STAGE(PG8_SA(0, 0), cA, voffA); PG8_STAGE(PG8_SA(0, 1), cA + hstep, voffA);
        if constexpr (Epi::HOOK) E.hook(tid);
        if (wr == 1) PG8_BAR;
        PG8_WAIT_V(2); PG8_BAR;
        PG8_STAGE(PG8_SB(1, 0), cB + kstep, voffB); PG8_STAGE(PG8_SA(1, 0), cA + kstep, voffA); PG8_STAGE(PG8_SB(1, 1), cB + hstep + kstep, voffB);
        PG8_WAIT_V(6); PG8_BAR;
    } else {
        PG8_STAGE(PG8_SB(0, 0), cB, voffB); PG8_STAGE(PG8_SA(0, 0), cA, voffA); PG8_STAGE(PG8_SB(0, 1), cB + hstep, voffB); PG8_STAGE(PG8_SA(0, 1), cA + hstep, voffA);
        if (wr == 1) PG8_BAR;
        PG8_WAIT_V(4); PG8_BAR;
        PG8_STAGE(PG8_SB(1, 0), cB + kstep, voffB); PG8_STAGE(PG8_SA(1, 0), cA + kstep, voffA); PG8_STAGE(PG8_SB(1, 1), cB + hstep + kstep, voffB);
        PG8_WAIT_V(6); PG8_BAR;
    }
    for (;;) {
        const bool has_next = S.next(ui + 1, nxt);
        const char* nA = has_next ? (const char*)g.A + (size_t)nxt.pm * tstep : cA; const char* nB = has_next ? (const char*)g.Bt + (size_t)nxt.pn * tstep : cB;
        for (int t = 0; t < nt; t += 2) {
            const bool last = (t == nt - 2);
            const char* a1 = cA + (size_t)(t + 1) * kstep;
            const char* a2 = last ? nA : cA + (size_t)(t + 2) * kstep; const char* b2 = last ? nB : cB + (size_t)(t + 2) * kstep;
            const char* a3 = a2 + kstep; const char* b3 = b2 + kstep;
            if (last && has_next) S.a_ready(nxt);
            if constexpr (SP2) {
            PG8_LDB(B0, 0, 0); PG8_LDB(B1, 0, 1); PG8_SCHED; PG8_LDA(At, 0, 0); PG8_STAGE(PG8_SA(1, 1), a1 + hstep, voffA);
            PG8_WAIT_V(8); PG8_WAIT_L(0); PG8_BAR; PG8_MMA(0, 0, At, B0); PG8_MMA(0, 1, At, B1); PG8_BAR; PG8_SCHED;
            PG8_LDA(At, 0, 1); PG8_STAGE(PG8_SB(0, 0), b2, voffB); PG8_STAGE(PG8_SB(0, 1), b2 + hstep, voffB); PG8_STAGE(PG8_SA(0, 0), a2, voffA);
            PG8_WAIT_V(8); PG8_WAIT_L(0); PG8_BAR; PG8_MMA(1, 0, At, B0); PG8_MMA(1, 1, At, B1); PG8_BAR; PG8_SCHED;
            PG8_LDB(B0, 1, 0); PG8_LDB(B1, 1, 1); PG8_SCHED; PG8_LDA(At, 1, 0); PG8_STAGE(PG8_SA(0, 1), a2 + hstep, voffA);
            PG8_WAIT_V(8); PG8_WAIT_L(0); PG8_BAR; PG8_MMA(0, 0, At, B0); PG8_MMA(0, 1, At, B1); PG8_BAR; PG8_SCHED;
            PG8_LDA(At, 1, 1); PG8_STAGE(PG8_SB(1, 0), b3, voffB); PG8_STAGE(PG8_SB(1, 1), b3 + hstep, voffB); PG8_STAGE(PG8_SA(1, 0), a3, voffA);
            PG8_WAIT_V(8); PG8_WAIT_L(0); PG8_BAR; PG8_MMA(1, 0, At, B0); PG8_MMA(1, 1, At, B1); PG8_BAR; PG8_SCHED;
            } else {
            PG8_LDB(B0, 0, 0); PG8_SCHED; PG8_LDA(At, 0, 0); PG8_STAGE(PG8_SA(1, 1), a1 + hstep, voffA);
            PG8_WAIT_L(8); PG8_BAR; PG8_WAIT_L(0); PG8_MMA(0, 0, At, B0); PG8_BAR; PG8_SCHED;
            PG8_LDB(B1, 0, 1); PG8_STAGE(PG8_SB(0, 0), b2, voffB);
            PG8_BAR; PG8_WAIT_L(0); PG8_MMA(0, 1, At, B1); PG8_BAR;
            PG8_LDA(At, 0, 1); PG8_STAGE(PG8_SA(0, 0), a2, voffA);
            PG8_BAR; PG8_WAIT_L(0); PG8_MMA(1, 0, At, B0); PG8_BAR; PG8_SCHED;
            PG8_STAGE(PG8_SB(0, 1), b2 + hstep, voffB);
            PG8_WAIT_V(6); PG8_BAR; PG8_MMA(1, 1, At, B1); PG8_BAR;
            PG8_LDB(B0, 1, 0); PG8_SCHED; PG8_LDA(At, 1, 0); PG8_STAGE(PG8_SA(0, 1), a2 + hstep, voffA);
            PG8_WAIT_L(8); PG8_BAR; PG8_WAIT_L(0); PG8_MMA(0, 0, At, B0); PG8_BAR; PG8_SCHED;
            PG8_LDB(B1, 1, 1); PG8_STAGE(PG8_SB(1, 0), b3, voffB);
            PG8_BAR; PG8_WAIT_L(0); PG8_MMA(0, 1, At, B1); PG8_BAR;
            PG8_LDA(At, 1, 1); PG8_STAGE(PG8_SA(1, 0), a3, voffA);
            PG8_BAR; PG8_WAIT_L(0); PG8_MMA(1, 0, At, B0); PG8_BAR; PG8_SCHED;
            PG8_STAGE(PG8_SB(1, 1), b3 + hstep, voffB);
            PG8_WAIT_V(6); PG8_BAR; PG8_MMA(1, 1, At, B1); PG8_BAR;
            }
        }
        if constexpr (ALIGN_EPI) { if (wr == 0) PG8_BAR; }
        if constexpr (!Epi::AFTER_DRAIN) { E(acc, cur, wr, wc, fr, fq); S.done(cur); }
        if (!has_next) break;
#pragma unroll
        for (int a = 0; a < 2; ++a)
#pragma unroll
            for (int b = 0; b < 2; ++b)
#pragma unroll
                for (int m = 0; m < 4; ++m)
#pragma unroll
                    for (int n = 0; n < 2; ++n) acc[a][b][m][n] = (f32x4){0.f, 0.f, 0.f, 0.f};
        cur = nxt; cA = nA; cB = nB; ++ui;
        if constexpr (ALIGN_EPI) { if (wr == 1) PG8_BAR; }
    }
    PG8_WAIT_V(0);
    if constexpr (!ALIGN_EPI) { if (wr == 0) PG8_BAR; }
    PG8_BAR;
    if constexpr (Epi::AFTER_DRAIN) { E.fused(acc, cur, wr, wc, fr, fq, lds, wid, lane); S.done(cur); }
#undef PG8_SA
#undef PG8_SB
#undef PG8_STAGE
#undef PG8_LDA
#undef PG8_LDB
#undef PG8_MMA
#undef PG8_WAIT_V
#undef PG8_WAIT_L
#undef PG8_BAR
#undef PG8_SCHED
}
}

#ifndef PG8_SP2
#define PG8_SP2 true
#endif
#ifndef PG8_ALIGN
#define PG8_ALIGN true
#endif
#define GAS __attribute__((address_space(1)))
#define LAS __attribute__((address_space(3)))
typedef unsigned short bf16;
typedef unsigned v4u __attribute__((ext_vector_type(4)));
typedef float f32x4 __attribute__((ext_vector_type(4)));
typedef short bf16x8 __attribute__((ext_vector_type(8)));
typedef GAS unsigned gu32;
typedef GAS unsigned long long gu64;
#define RLX_AGENT __ATOMIC_RELAXED, __HIP_MEMORY_SCOPE_AGENT
#define LDS_WAIT() asm volatile("s_waitcnt lgkmcnt(0)" ::: "memory")
#define VM_WAIT() asm volatile("s_waitcnt vmcnt(0)" ::: "memory")
__device__ __forceinline__ unsigned long long rt() { return __builtin_amdgcn_s_memrealtime(); }
__device__ __forceinline__ unsigned f2bf(float f) { unsigned u = __builtin_bit_cast(unsigned, f); return (u + 0x7fffu + ((u >> 16) & 1u)) >> 16; }
__device__ __forceinline__ unsigned pk2(float lo, float hi) { return f2bf(lo) | (f2bf(hi) << 16); }

#define XB_TMO      128
#define XB_XCNT(j)  (256  + 64 * (j))
#define XB_XSUB(j)  (1280 + 64 * (j))
#define XB_XGEN(j)  (2304 + 64 * (j))
#define XB_TOP      3328
#define XB_TOPGEN   3392
#define XCD_BAR_WORDS 3456
#define XB_LSUB(j)  (3456 + 64 * (j))
#define XB_LGEN(j)  (4480 + 64 * (j))
#define XB_GMAP(g)  (5504 + 64 * (g))
#define XB_BAD      6016
#define XB_WORDS_ALL 6080
#define XB_SPIN_CAP (1u << 18)

__device__ __forceinline__ unsigned xb_ld(unsigned* p)              { return __hip_atomic_load(p, __ATOMIC_RELAXED, __HIP_MEMORY_SCOPE_AGENT); }
__device__ __forceinline__ unsigned xb_add(unsigned* p, unsigned v) { return __hip_atomic_fetch_add(p, v, __ATOMIC_RELAXED, __HIP_MEMORY_SCOPE_AGENT); }
__device__ __forceinline__ unsigned xb_xcc_id() { return (unsigned)__builtin_amdgcn_s_getreg((3 << 11) | 20) & 0xFu; }
#define XB_SPIN(cond, bar) do { unsigned _sp = 0; while (cond) { __builtin_amdgcn_s_sleep(1); \
    if ((++_sp & 255u) == 0u) { if (xb_ld(&(bar)[XB_TMO])) break; if (_sp > XB_SPIN_CAP) { atomicAdd(&(bar)[XB_TMO], 1u); break; } } } } while (0)

struct XcdBarrier {
    unsigned* bar; unsigned x;
    volatile LAS unsigned* st;
};

__device__ __forceinline__ XcdBarrier xcd_barrier_post(unsigned* bar, volatile LAS unsigned* st) {
    XcdBarrier b; b.bar = bar; b.x = xb_xcc_id(); b.st = st;
    if (threadIdx.x == 0) (void)xb_add(&bar[XB_XCNT(b.x)], 1u);
    return b;
}
__device__ __forceinline__ void xcd_barrier_complete(unsigned* bar, unsigned x, unsigned& nloc, unsigned& nx) {
    const unsigned G = gridDim.x * gridDim.y * gridDim.z;
    unsigned sum, cnt, mine, sp = 0u;
    for (;;) {
        sum = 0u; cnt = 0u; mine = 0u;
#pragma unroll
        for (unsigned j = 0; j < 16; ++j) { const unsigned c = xb_ld(&bar[XB_XCNT(j)]); sum += c; cnt += (c > 0u) ? 1u : 0u; mine = (j == x) ? c : mine; }
        if (sum == G) break;
        __builtin_amdgcn_s_sleep(1);
        if ((++sp & 255u) == 0u) { if (xb_ld(&bar[XB_TMO])) break; if (sp > XB_SPIN_CAP) { atomicAdd(&bar[XB_TMO], 1u); break; } }
    }
    nloc = mine > 0u ? mine : 1u; nx = cnt > 0u ? cnt : 1u;
}

__device__ __forceinline__ void xcd_barrier(const XcdBarrier& b) {
    asm volatile("s_waitcnt vmcnt(0)" ::: "memory");
    __syncthreads();
    if (threadIdx.x == 0) {
        unsigned* bar = b.bar;
        __builtin_amdgcn_s_waitcnt(0);
        unsigned nloc = b.st[0], nx = b.st[1];
        if (nloc == 0u) { xcd_barrier_complete(bar, b.x, nloc, nx); b.st[0] = nloc; b.st[1] = nx; }
        const unsigned old = xb_add(&bar[XB_XSUB(b.x)], 1u);
        const unsigned gen = old / nloc;
        if (old + 1u == (gen + 1u) * nloc) {
            __builtin_amdgcn_fence(__ATOMIC_RELEASE, "agent");
            asm volatile("s_waitcnt vmcnt(0)" ::: "memory");
            const unsigned og = xb_add(&bar[XB_TOP], 1u);
            const unsigned tg = og / nx;
            if (og + 1u == (tg + 1u) * nx) xb_add(&bar[XB_TOPGEN], 1u);
            else XB_SPIN(xb_ld(&bar[XB_TOPGEN]) == tg, bar);
            __builtin_amdgcn_fence(__ATOMIC_ACQUIRE, "agent");
            xb_add(&bar[XB_XGEN(b.x)], 1u);
            asm volatile("s_waitcnt vmcnt(0)" ::: "memory");
        } else {
            XB_SPIN(xb_ld(&bar[XB_XGEN(b.x)]) == gen, bar);
            __builtin_amdgcn_fence(__ATOMIC_ACQUIRE, "agent");
            asm volatile("s_waitcnt vmcnt(0)" ::: "memory");
        }
    }
    __syncthreads();
}

__device__ __forceinline__ void xcd_local_setup(const XcdBarrier& b) {
    unsigned* w = &b.bar[XB_GMAP(blockIdx.x & 7u)];
    const unsigned mine = b.x + 1u, old = atomicCAS(w, 0u, mine);
    if (old != 0u && old != mine) atomicOr(&b.bar[XB_BAD], 1u);
}
__device__ __forceinline__ bool xcd_local_ok(const XcdBarrier& b) {
    const unsigned G = gridDim.x * gridDim.y * gridDim.z;
    if ((G & 7u) != 0u || xb_ld(&b.bar[XB_BAD]) != 0u) return false;
    unsigned populated = 0u; bool ok = true;
#pragma unroll
    for (unsigned j = 0; j < 16; ++j) { const unsigned c = xb_ld(&b.bar[XB_XCNT(j)]); if (c != 0u) { ++populated; if (c != G / 8u) ok = false; } }
    return ok && populated == 8u;
}
__device__ __forceinline__ void xcd_local_barrier(const XcdBarrier& b) {
    asm volatile("s_waitcnt vmcnt(0)" ::: "memory");
    __syncthreads();
    if (threadIdx.x == 0) {
        unsigned* bar = b.bar; const unsigned nloc = (gridDim.x * gridDim.y * gridDim.z) / 8u;
        __builtin_amdgcn_s_waitcnt(0);
        const unsigned old = xb_add(&bar[XB_LSUB(b.x)], 1u), gen = old / nloc;
        if (old + 1u == (gen + 1u) * nloc) xb_add(&bar[XB_LGEN(b.x)], 1u);
        else XB_SPIN(xb_ld(&bar[XB_LGEN(b.x)]) == gen, bar);
        __builtin_amdgcn_fence(__ATOMIC_ACQUIRE, "agent");
        asm volatile("s_waitcnt vmcnt(0)" ::: "memory");
    }
    __syncthreads();
}

constexpr int NWAVES = 8;
constexpr int BATCH = 8, SEQ = 4096, DMODEL = 1024, MTOK = BATCH * SEQ, INC = 3072, DFF = 2816, NGU = 2 * DFF;
constexpr float EPS = 1e-6f;
constexpr size_t MiB = 1u << 20;
constexpr size_t WS_CTL = 0, CTL_ZERO_BYTES = 65536;
constexpr size_t WS_WIN = 2 * MiB, WS_WOUT = 8 * MiB, WS_WGU = 10 * MiB, WS_WD = 22 * MiB, WS_SSQ = 28 * MiB;
constexpr size_t WS_PROJ = 32 * MiB;
constexpr size_t WS_XN = 224 * MiB;
constexpr size_t WS_MIX = 352 * MiB;
constexpr size_t WS_RINV = 30 * MiB;
constexpr size_t WS_XH = 288 * MiB;
constexpr size_t WS_ACT = 32 * MiB;
constexpr size_t WS_END = 416 * MiB;
constexpr int CW_BAR = 4096;
constexpr int RING_OFF = 0, RING_BYTES = 131072;
constexpr int LDSCTL_OFF = RING_BYTES, MISC_OFF = LDSCTL_OFF + 320;
constexpr int TAB_OFF = RING_BYTES + 1024, WSF_OFF = RING_BYTES + 5120, RSTD_OFF = RING_BYTES + 9216;
constexpr int LDS_BYTES = 147456;

namespace att {
using bf16x8 = __attribute__((ext_vector_type(8))) short;
using s16x4 = __attribute__((ext_vector_type(4))) short;
using f32x16 = __attribute__((ext_vector_type(16))) float;
using f32x4v = __attribute__((ext_vector_type(4))) float;
using u32x4 = __attribute__((ext_vector_type(4))) unsigned;
using u32x2 = __attribute__((ext_vector_type(2))) unsigned;
typedef unsigned short bf16;
constexpr int SEQ = 4096, PP = 512  , MP = 1024  ;
constexpr float LOG2E = 1.4426950408889634f, EPS = 1e-6f;
#define MFMA32(a, b, c) __builtin_amdgcn_mfma_f32_32x32x16_bf16(a, b, c, 0, 0, 0)
#define ATT_WAIT_BAR() asm volatile("s_waitcnt vmcnt(0) lgkmcnt(0)\n\ts_barrier" ::: "memory")
#define ATT_LDS_BAR() asm volatile("s_waitcnt lgkmcnt(0)\n\ts_barrier" ::: "memory")
typedef __attribute__((address_space(3))) const char* lds_cptr;
typedef __attribute__((address_space(3))) char* lds_ptr;
typedef short v4i16_t __attribute__((ext_vector_type(4)));
__device__ __forceinline__ int crow(int r, int hi) { return (r & 3) + 8 * (r >> 2) + 4 * hi; }
__device__ __forceinline__ void glds16(const void* gsrc, unsigned lds_dst) { unsigned keep;
#if MK_PROBE_DMA2
    asm volatile("s_mov_b32 %0, m0\n\ts_mov_b32 m0, %2\n\ts_nop 0\n\tglobal_load_lds_dwordx4 %1, off\n\tglobal_load_lds_dwordx4 %1, off\n\ts_mov_b32 m0, %0" : "=&s"(keep) : "v"(gsrc), "s"(lds_dst) : "memory"); }
#else
    asm volatile("s_mov_b32 %0, m0\n\ts_mov_b32 m0, %2\n\ts_nop 0\n\tglobal_load_lds_dwordx4 %1, off\n\ts_mov_b32 m0, %0" : "=&s"(keep) : "v"(gsrc), "s"(lds_dst) : "memory"); }
#endif
__device__ __forceinline__ s16x4 vtr(lds_cptr p) { return __builtin_bit_cast(s16x4, __builtin_amdgcn_ds_read_tr16_b64_v4i16((__attribute__((address_space(3))) v4i16_t*)p)); }
typedef float f32x2_t __attribute__((ext_vector_type(2))); typedef __bf16 bf16x2_t __attribute__((ext_vector_type(2)));
__device__ __forceinline__ unsigned cvtpk(float lo, float hi) { f32x2_t v = {lo, hi}; bf16x2_t b = __builtin_convertvector(v, bf16x2_t); return __builtin_bit_cast(unsigned, b); }
__device__ __forceinline__ float halves_max(float m) { auto rr = __builtin_amdgcn_permlane32_swap(__float_as_uint(m), __float_as_uint(m), false, false); return fmaxf(__uint_as_float(rr[0]), __uint_as_float(rr[1])); }
__device__ __forceinline__ float halves_sum(float m) { auto rr = __builtin_amdgcn_permlane32_swap(__float_as_uint(m), __float_as_uint(m), false, false); return __uint_as_float(rr[0]) + __uint_as_float(rr[1]); }
__device__ __forceinline__ int t5_bucket(int rel) {
    const int n = rel < 0 ? -rel : rel; int b;
    if (n < 8) b = n; else if (n < 12) b = 8; else if (n < 16) b = 9; else if (n < 23) b = 10; else if (n < 32) b = 11;
    else if (n < 46) b = 12; else if (n < 64) b = 13; else if (n < 91) b = 14; else b = 15;
    return b + (rel > 0 ? 16 : 0);
}
__device__ __forceinline__ float rowmax32(const f32x16& p0, const f32x16& p1) {
    float a = fmaxf(fmaxf(p0[0], p0[1]), p1[0]), b = fmaxf(fmaxf(p0[2], p0[3]), p1[1]); a = fmaxf(fmaxf(a, p1[2]), p1[3]);
#pragma unroll
    for (int r = 4; r < 16; r += 4) { a = fmaxf(fmaxf(a, p0[r]), p0[r + 1]); b = fmaxf(fmaxf(b, p0[r + 2]), p0[r + 3]); a = fmaxf(fmaxf(a, p1[r]), p1[r + 1]); b = fmaxf(fmaxf(b, p1[r + 2]), p1[r + 3]); }
    return halves_max(fmaxf(a, b));
}
#define PACK4(P, B) (u32x4){cvtpk(P[B], P[B + 1]), cvtpk(P[B + 2], P[B + 3]), cvtpk(P[B + 4], P[B + 5]), cvtpk(P[B + 6], P[B + 7])}

template <int THR> __device__ __forceinline__ void diff_unit(int b, int h, int u, const bf16* DQ, const bf16* DK, const bf16* DV, bf16* MIX, lds_cptr tabh, float bfar, float mbound, float lam, const float* onw,
                                                           lds_ptr shm, lds_ptr wsfb, bf16x8 (&qr)[4], bool pre, int nb, int nh, int nu) {
    const int tid = threadIdx.x; int lane = tid & 63; asm volatile("" : "+v"(lane));
    const int r32 = lane & 31, hi = lane >> 5; const int wid = __builtin_amdgcn_readfirstlane(tid >> 6), rbk = wid & 3, c = wid >> 2;
    const long rowbase = (long)b * SEQ; const int q0w = u * 128 + rbk * 32, cw = q0w >> 6, NT = 2 * u + 2;
    const unsigned lds0 = (unsigned)(uintptr_t)shm;
    constexpr int KS = 16384, VOFF = 49152;
    __attribute__((address_space(3))) float* wsf = (__attribute__((address_space(3))) float*)(wsfb) + wid * 128;
    const bf16* ksrc = DK + ((size_t)((b * 4 + h) * 64) << 13) + wid * 1024 + lane * 8;
    const bf16* vsrc = DV + ((size_t)((b * 4 + h) * 64) << 13) + wid * 1024 + lane * 8;
#define DMA_K(t, off) do { const unsigned d_ = (unsigned)__builtin_amdgcn_readfirstlane(lds0 + (off) + wid * 2048); glds16(ksrc + ((long)(t) << 13), d_); glds16(ksrc + ((long)(t) << 13) + 512, d_ + 1024); } while (0)
#define DMA_V(t, off) do { const unsigned d_ = (unsigned)__builtin_amdgcn_readfirstlane(lds0 + VOFF + (off) + wid * 2048); glds16(vsrc + ((long)(t) << 13), d_); glds16(vsrc + ((long)(t) << 13) + 512, d_ + 1024); } while (0)
#if MK_PROBE_BAR2
#define WAIT_BAR(N) asm volatile("s_waitcnt vmcnt(" #N ") lgkmcnt(0)\n\ts_barrier\n\ts_barrier" ::: "memory")
#else
#define WAIT_BAR(N) asm volatile("s_waitcnt vmcnt(" #N ") lgkmcnt(0)\n\ts_barrier" ::: "memory")
#endif
#define SBAR() __builtin_amdgcn_sched_barrier(0)
#define PIN(x) asm volatile("" : "+v"(x))
    if (!pre) {
        const bf16* qp = DQ + (rowbase + q0w + r32) * PP + h * 128 + c * 64 + hi * 8;
#pragma unroll
        for (int d0 = 0; d0 < 4; ++d0) qr[d0] = *reinterpret_cast<const bf16x8*>(qp + d0 * 16);
        DMA_K(0, 0); DMA_V(0, 0); DMA_K(1, KS); }
    f32x16 o[4];
#pragma unroll
    for (int d = 0; d < 4; ++d) o[d] = f32x16{};
    float mhat = 0.f, l = 0.f; bool resc = false;
    f32x16 negm;
#pragma unroll
    for (int r = 0; r < 16; ++r) negm[r] = bfar;
    PIN(negm);
    const lds_cptr kp = (lds_cptr)shm + (c * 8 + hi) * 1024 + r32 * 16;
    const lds_cptr vp = (lds_cptr)shm + VOFF + ((lane >> 4) & 1) * 32 + (lane & 3) * 8 + (4 * hi + ((lane & 15) >> 2)) * 64;
    int off_prev = 2 * KS, off_cur = 0, off_next = KS;
#define ROT() do { off_prev = off_cur; off_cur = off_next; off_next = (off_next == 2 * KS) ? 0 : off_next + KS; } while (0)
#define LDK(i) (*(const __attribute__((address_space(3))) bf16x8*)(kq_ + ((i) >> 1) * 2048 + ((i) & 1) * 512))
#define LDVF(dst, j) do { const s16x4 lo_ = vtr(vq_ + ((j) >> 2) * 4096 + ((j) & 3) * 1024), hh_ = vtr(vq_ + ((j) >> 2) * 4096 + ((j) & 3) * 1024 + 512); \
        dst = (bf16x8){lo_[0], lo_[1], lo_[2], lo_[3], hh_[0], hh_[1], hh_[2], hh_[3]}; } while (0)
#define ISSUE(s) do { if ((s) + 2 < NT) DMA_K((s) + 2, off_prev); if ((s) + 1 < NT) DMA_V((s) + 1, off_next); } while (0)
#define ENDW(s) do { if ((s) + 2 < NT) WAIT_BAR(4); else if ((s) + 1 < NT) WAIT_BAR(2); else WAIT_BAR(0); } while (0)
#define NEARBIAS(C0, C1, t) do { if ((t) >= cw - 2) { const __attribute__((address_space(3))) float* tb_ = (const __attribute__((address_space(3))) float*)tabh + (64 * (t) - (q0w + r32) + 4 * hi + 191); \
        _Pragma("unroll") for (int r = 0; r < 16; ++r) { C0[r] += tb_[(r & 3) + 8 * (r >> 2)]; C1[r] += tb_[32 + (r & 3) + 8 * (r >> 2)]; } } } while (0)
#define DECIDE(C0, C1, FIRST) do { const float rm_ = rowmax32(C0, C1); resc = false; \
        if ((FIRST) || __any(rm_ > (float)THR)) { const float dl_ = (FIRST) ? rm_ : fmaxf(rm_, 0.f); mhat += dl_; \
            _Pragma("unroll") for (int r = 0; r < 16; ++r) { C0[r] -= dl_; C1[r] -= dl_; } \
            _Pragma("unroll") for (int r = 0; r < 16; ++r) negm[r] = bfar - mhat; PIN(negm); \
            if (!(FIRST)) { const float f_ = __builtin_amdgcn_exp2f(-dl_); l *= f_; if (hi == 0) wsf[r32] = f_; resc = true; } } } while (0)
#define RESC() do { if (resc) { asm volatile("s_waitcnt lgkmcnt(0)" ::: "memory"); \
        _Pragma("unroll") for (int r = 0; r < 16; ++r) { const float fr_ = wsf[crow(r, hi)]; _Pragma("unroll") for (int d = 0; d < 4; ++d) o[d][r] *= fr_; } \
        asm volatile("s_waitcnt lgkmcnt(0)" ::: "memory"); } } while (0)
    u32x4 pw0, pw1, pw2, pw3; float dum0_ = 0.f, dum1_ = 0.f;
#define GAPA(MF, KR, E, B, PW, I0, PE, PB) do { MF; KR; sacc_ += E[B]; sacc_ += E[B + 1]; sacc_ += E[B + 2]; sacc_ += E[B + 3]; PIN(sacc_); \
        PW[I0] = cvtpk(PE[PB], PE[PB + 1]); PW[I0 + 1] = cvtpk(PE[PB + 2], PE[PB + 3]); PIN(PW); SBAR(); } while (0)
#define GAPB(MF, VR, X, B) do { MF; VR; X[B] = __builtin_amdgcn_exp2f(X[B]); X[B + 1] = __builtin_amdgcn_exp2f(X[B + 1]); PIN(X); if (MK_PROBE_DFVALU) asm volatile("v_add_f32 %0, %0, %0\n\tv_add_f32 %1, %1, %1" : "+v"(dum0_), "+v"(dum1_)); SBAR(); } while (0)
#define QKT(C0, C1) do { const lds_cptr kq_ = kp + off_cur; \
        _Pragma("unroll") for (int d0 = 0; d0 < 4; ++d0) { const bf16x8 k0_ = LDK(2 * d0), k1_ = LDK(2 * d0 + 1); \
            if (d0 == 0) { C0 = MFMA32(k0_, qr[0], negm); C1 = MFMA32(k1_, qr[0], negm); } else { C0 = MFMA32(k0_, qr[d0], C0); C1 = MFMA32(k1_, qr[d0], C1); } } } while (0)
#define PVDRAIN(E0, E1) do { float sacc_ = 0.f; _Pragma("unroll") for (int r = 0; r < 16; ++r) sacc_ += E0[r] + E1[r]; l += sacc_; \
        pw0 = PACK4(E0, 0); pw1 = PACK4(E0, 8); pw2 = PACK4(E1, 0); pw3 = PACK4(E1, 8); SBAR(); \
        const lds_cptr vq_ = vp + off_prev; \
        _Pragma("unroll") for (int d0 = 0; d0 < 4; ++d0) { bf16x8 va_, vb_, vc_, vd_; LDVF(va_, 4 * d0); LDVF(vb_, 4 * d0 + 1); LDVF(vc_, 4 * d0 + 2); LDVF(vd_, 4 * d0 + 3); \
            o[d0] = MFMA32(__builtin_bit_cast(bf16x8, pw0), va_, o[d0]); o[d0] = MFMA32(__builtin_bit_cast(bf16x8, pw1), vb_, o[d0]); \
            o[d0] = MFMA32(__builtin_bit_cast(bf16x8, pw2), vc_, o[d0]); o[d0] = MFMA32(__builtin_bit_cast(bf16x8, pw3), vd_, o[d0]); SBAR(); } } while (0)
#define STEP(C0, C1, E0, E1, s) do { SBAR(); \
        const lds_cptr kq_ = kp + off_cur; const lds_cptr vq_ = vp + off_prev; \
        bf16x8 ka_ = LDK(0), kb_ = LDK(1), kc_, kd_, va_, vb_; SBAR(); \
        float sacc_ = E0[0] + E0[1]; \
        GAPA(C0 = MFMA32(ka_, qr[0], negm), kc_ = LDK(2), E0, 2,  pw0, 0, E0, 0); \
        GAPA(C1 = MFMA32(kb_, qr[0], negm), kd_ = LDK(3), E0, 6,  pw0, 2, E0, 4); \
        if ((s) + 2 < NT) DMA_K((s) + 2, off_prev); \
        GAPA(C0 = MFMA32(kc_, qr[1], C0),   ka_ = LDK(4), E0, 10, pw1, 0, E0, 8); \
        { MFMA_LAST4_(C1, kd_, 1); kb_ = LDK(5); sacc_ += E0[14]; sacc_ += E0[15]; sacc_ += E1[0]; sacc_ += E1[1]; PIN(sacc_); pw1[2] = cvtpk(E0[12], E0[13]); pw1[3] = cvtpk(E0[14], E0[15]); PIN(pw1); SBAR(); } \
        GAPA(C0 = MFMA32(ka_, qr[2], C0),   kc_ = LDK(6), E1, 2,  pw2, 0, E1, 0); \
        GAPA(C1 = MFMA32(kb_, qr[2], C1),   kd_ = LDK(7), E1, 6,  pw2, 2, E1, 4); \
        if ((s) + 1 < NT) DMA_V((s) + 1, off_next); \
        GAPA(C0 = MFMA32(kc_, qr[3], C0),   LDVF(va_, 0), E1, 10, pw3, 0, E1, 8); \
        { C1 = MFMA32(kd_, qr[3], C1); LDVF(vb_, 1); sacc_ += E1[14]; sacc_ += E1[15]; PIN(sacc_); pw3[2] = cvtpk(E1[12], E1[13]); pw3[3] = cvtpk(E1[14], E1[15]); PIN(pw3); SBAR(); } \
        l += sacc_; \
        NEARBIAS(C0, C1, s); \
        resc = false; if (chk) DECIDE(C0, C1, false); \
        SBAR(); if (MK_DIFF_PRIO_B) __builtin_amdgcn_s_setprio(1); \
        GAPB(o[0] = MFMA32(__builtin_bit_cast(bf16x8, pw0), va_, o[0]), LDVF(va_, 2),  C0, 0); \
        GAPB(o[0] = MFMA32(__builtin_bit_cast(bf16x8, pw1), vb_, o[0]), LDVF(vb_, 3),  C0, 2); \
        GAPB(o[0] = MFMA32(__builtin_bit_cast(bf16x8, pw2), va_, o[0]), LDVF(va_, 4),  C0, 4); \
        GAPB(o[0] = MFMA32(__builtin_bit_cast(bf16x8, pw3), vb_, o[0]), LDVF(vb_, 5),  C0, 6); \
        GAPB(o[1] = MFMA32(__builtin_bit_cast(bf16x8, pw0), va_, o[1]), LDVF(va_, 6),  C0, 8); \
        GAPB(o[1] = MFMA32(__builtin_bit_cast(bf16x8, pw1), vb_, o[1]), LDVF(vb_, 7),  C0, 10); \
        GAPB(o[1] = MFMA32(__builtin_bit_cast(bf16x8, pw2), va_, o[1]), LDVF(va_, 8),  C0, 12); \
        GAPB(o[1] = MFMA32(__builtin_bit_cast(bf16x8, pw3), vb_, o[1]), LDVF(vb_, 9),  C0, 14); \
        GAPB(o[2] = MFMA32(__builtin_bit_cast(bf16x8, pw0), va_, o[2]), LDVF(va_, 10), C1, 0); \
        GAPB(o[2] = MFMA32(__builtin_bit_cast(bf16x8, pw1), vb_, o[2]), LDVF(vb_, 11), C1, 2); \
        GAPB(o[2] = MFMA32(__builtin_bit_cast(bf16x8, pw2), va_, o[2]), LDVF(va_, 12), C1, 4); \
        GAPB(o[2] = MFMA32(__builtin_bit_cast(bf16x8, pw3), vb_, o[2]), LDVF(vb_, 13), C1, 6); \
        GAPB(o[3] = MFMA32(__builtin_bit_cast(bf16x8, pw0), va_, o[3]), LDVF(va_, 14), C1, 8); \
        GAPB(o[3] = MFMA32(__builtin_bit_cast(bf16x8, pw1), vb_, o[3]), LDVF(vb_, 15), C1, 10); \
        GAPB(o[3] = MFMA32(__builtin_bit_cast(bf16x8, pw2), va_, o[3]), (void)0,       C1, 12); \
        GAPB(o[3] = MFMA32(__builtin_bit_cast(bf16x8, pw3), vb_, o[3]), (void)0,       C1, 14); \
        if (MK_DIFF_PRIO_B) __builtin_amdgcn_s_setprio(0); \
    } while (0)
#define MFMA_LAST4_(C1, kd_, q) C1 = MFMA32(kd_, qr[q], C1)
    f32x16 pA0, pA1, pB0, pB1;
    if (MK_DIFF_PRIO_STATIC && wid >= 4) __builtin_amdgcn_s_setprio(1);
    WAIT_BAR(4);
    QKT(pA0, pA1); ISSUE(0); NEARBIAS(pA0, pA1, 0); DECIDE(pA0, pA1, true);
    const bool chk = __any(mbound - mhat > 90.f);
#pragma unroll
    for (int r = 0; r < 16; ++r) { pA0[r] = __builtin_amdgcn_exp2f(pA0[r]); pA1[r] = __builtin_amdgcn_exp2f(pA1[r]); }
    ENDW(0); ROT();
    int s = 1;
    for (; s + 1 <= cw; s += 2) {
        STEP(pB0, pB1, pA0, pA1, s);     ENDW(s);     RESC(); ROT();
        STEP(pA0, pA1, pB0, pB1, s + 1); ENDW(s + 1); RESC(); ROT();
    }
    if (s <= cw) { STEP(pB0, pB1, pA0, pA1, s); ENDW(s); RESC(); ROT(); ++s; }
    else {
#pragma unroll
        for (int r = 0; r < 16; ++r) { pB0[r] = pA0[r]; pB1[r] = pA1[r]; } }
    PVDRAIN(pB0, pB1);
    if (s < NT) { ISSUE(s); ENDW(s); ROT(); }
#undef MFMA_LAST4_
#undef STEP
#undef PVDRAIN
#undef QKT
#undef GAPA
#undef GAPB
#undef RESC
#undef DECIDE
#undef NEARBIAS
#undef ENDW
#undef ISSUE
#undef LDVF
#undef LDK
#undef ROT
#undef DMA_K
#undef DMA_V
    if (MK_DIFF_PRIO_STATIC) __builtin_amdgcn_s_setprio(0);
    l = halves_sum(l);
    int r32e = r32, hie = hi; asm volatile("" : "+v"(r32e), "+v"(hie));
    if (hie == 0) wsf[r32e] = (c ? lam : 1.0f) * __builtin_amdgcn_rcpf(l);
    ATT_WAIT_BAR();
    if (nu >= 0) {
        const bf16* ksn = DK + ((size_t)((nb * 4 + nh) * 64) << 13) + wid * 1024 + lane * 8; const bf16* vsn = DV + ((size_t)((nb * 4 + nh) * 64) << 13) + wid * 1024 + lane * 8;
        const unsigned dk_ = (unsigned)__builtin_amdgcn_readfirstlane(lds0 + wid * 2048), dv_ = (unsigned)__builtin_amdgcn_readfirstlane(lds0 + VOFF + wid * 2048);
        glds16(ksn, dk_); glds16(ksn + 512, dk_ + 1024); glds16(vsn, dv_); glds16(vsn + 512, dv_ + 1024); glds16(ksn + 8192, dk_ + KS); glds16(ksn + 8192 + 512, dk_ + KS + 1024);
        const bf16* qn = DQ + ((long)nb * SEQ + nu * 128 + rbk * 32 + r32) * PP + nh * 128 + c * 64 + hi * 8;
#pragma unroll
        for (int d0 = 0; d0 < 4; ++d0) qr[d0] = *reinterpret_cast<const bf16x8*>(qn + d0 * 16); }
    const int k16 = r32e & 15, rsel = 2 * hie + (r32e >> 4);
    const f32x4v wv0 = *(const f32x4v*)(onw + 8 * k16), wv1 = *(const f32x4v*)(onw + 8 * k16 + 4);
    lds_ptr stg = shm + 65536 + rbk * 16384;
#define DSTG(q, d) ((__attribute__((address_space(3))) float*)(stg + (q) * 512 + (((8 * (d) + (r32e >> 2)) ^ ((q) & 15)) << 4) + (r32e & 3) * 4))
    if (c == 0) {
#pragma unroll
        for (int r = 0; r < 16; ++r) { const int q = crow(r, hie); const float a = wsf[q]; *DSTG(q, 2) = o[2][r] * a; *DSTG(q, 3) = o[3][r] * a; } }
    else {
#pragma unroll
        for (int r = 0; r < 16; ++r) { const int q = crow(r, hie); const float a = wsf[q]; *DSTG(q, 0) = o[0][r] * a; *DSTG(q, 1) = o[1][r] * a; } }
    ATT_LDS_BAR();
    if (c == 0) {
#pragma unroll
        for (int r = 0; r < 16; ++r) { const int q = crow(r, hie); const float a = wsf[q]; *DSTG(q, 0) = o[0][r] * a - *DSTG(q, 0); *DSTG(q, 1) = o[1][r] * a - *DSTG(q, 1); } }
    else {
#pragma unroll
        for (int r = 0; r < 16; ++r) { const int q = crow(r, hie); const float a = wsf[q]; *DSTG(q, 2) = *DSTG(q, 2) - o[2][r] * a; *DSTG(q, 3) = *DSTG(q, 3) - o[3][r] * a; } }
#undef DSTG
    ATT_LDS_BAR();
    { float ss = 0.f;
#pragma unroll
      for (int k = 0; k < 16; ++k) { const f32x4v v = *(const __attribute__((address_space(3))) f32x4v*)(stg + r32e * 512 + (((16 * hie + k) ^ (r32e & 15)) << 4)); ss += (v[0] * v[0] + v[1] * v[1]) + (v[2] * v[2] + v[3] * v[3]); }
      ss = halves_sum(ss);
      if (hie == 0) wsf[64 + r32e] = 0.8f * __builtin_amdgcn_rsqf(ss * (1.0f / 128.0f) + EPS);
      asm volatile("s_waitcnt lgkmcnt(0)" ::: "memory");
      bf16* op = MIX + (rowbase + q0w) * MP + h * 128 + 8 * k16;
      asm volatile("s_waitcnt vmcnt(0)" ::: "memory");
#pragma unroll
      for (int i = 0; i < 4; ++i) { const int q = 16 * c + 4 * i + rsel; const float rs = wsf[64 + q];
          const f32x4v v0 = *(const __attribute__((address_space(3))) f32x4v*)(stg + q * 512 + (((2 * k16) ^ (q & 15)) << 4));
          const f32x4v v1 = *(const __attribute__((address_space(3))) f32x4v*)(stg + q * 512 + (((2 * k16 + 1) ^ (q & 15)) << 4));
          u32x4 w; w.x = cvtpk(v0[0] * rs * wv0[0], v0[1] * rs * wv0[1]); w.y = cvtpk(v0[2] * rs * wv0[2], v0[3] * rs * wv0[3]);
          w.z = cvtpk(v1[0] * rs * wv1[0], v1[1] * rs * wv1[1]); w.w = cvtpk(v1[2] * rs * wv1[2], v1[3] * rs * wv1[3]);
          *(u32x4*)(op + (long)q * MP) = w; }
    }
    ATT_LDS_BAR();
#undef WAIT_BAR
#undef SBAR
#undef PIN
}

__device__ __forceinline__ void sb_item(int b, int h, int rb, const bf16* SQ, const bf16* SK, const bf16* SV, bf16* MIX, const float* onw, lds_ptr shm, lds_ptr wsfb) {
    int lane = threadIdx.x & 63; asm volatile("" : "+v"(lane));
    const int r32 = lane & 31, hi = lane >> 5;
    const long rowbase = (long)b * SEQ; const int q0w = rb * 32, tq = q0w >> 6, qloc = (q0w & 63) + r32;
    const unsigned lds0 = (unsigned)__builtin_amdgcn_readfirstlane((unsigned)(uintptr_t)shm);
    __attribute__((address_space(3))) float* wsf = (__attribute__((address_space(3))) float*)(wsfb);
    const bf16* ksrc = SK + ((size_t)((b * 8 + h) * 64) << 12) + hi * 512 + (16 * ((r32 >> 2) & 1) + (r32 & 3) + 4 * (r32 >> 3)) * 8;
    const bf16* vsrc = SV + ((size_t)((b * 8 + h) * 64) << 12) + lane * 8;
#define SB_DMA_V(t, buf) do { _Pragma("unroll") for (int i_ = 0; i_ < 8; ++i_) glds16(vsrc + ((long)(t) << 12) + i_ * 512, lds0 + (buf) * 8192 + i_ * 1024); } while (0)
#define SB_LD_K(dst, t) do { _Pragma("unroll") for (int d_ = 0; d_ < 4; ++d_) { dst[2 * d_] = *reinterpret_cast<const bf16x8*>(ksrc + ((long)(t) << 12) + d_ * 1024); \
        dst[2 * d_ + 1] = *reinterpret_cast<const bf16x8*>(ksrc + ((long)(t) << 12) + d_ * 1024 + 256); } } while (0)
    bf16x8 qr[4], kfA[8], kfB[8];
    asm volatile("s_waitcnt lgkmcnt(0)" ::: "memory");
    SB_DMA_V(tq, 0); SB_LD_K(kfA, tq);
    { const bf16* qp = SQ + (rowbase + q0w + r32) * PP + h * 64 + hi * 8;
#pragma unroll
      for (int d0 = 0; d0 < 4; ++d0) qr[d0] = *reinterpret_cast<const bf16x8*>(qp + d0 * 16); }
    f32x16 o[2]; o[0] = f32x16{}; o[1] = f32x16{};
    float carry = 1.0f;
    const lds_cptr vp = (lds_cptr)shm + ((lane >> 4) & 1) * 32 + (lane & 3) * 8 + (16 * hi + ((lane & 15) >> 2)) * 64;
#define SB_TILE(KU, KL, DIAG, t) do { \
        const int vb_ = ((tq - (t)) & 1) * 8192; \
        asm volatile("" ::: "memory"); __builtin_amdgcn_s_waitcnt(0x0070); asm volatile("" ::: "memory");     \
        if ((t) > 0) { SB_DMA_V((t) - 1, ((tq - (t)) & 1) ^ 1); SB_LD_K(KL, (t) - 1); } \
        f32x16 p0 = f32x16{}, p1 = f32x16{}; \
        _Pragma("unroll") for (int d0 = 0; d0 < 4; ++d0) { p0 = MFMA32(KU[2 * d0], qr[d0], p0); p1 = MFMA32(KU[2 * d0 + 1], qr[d0], p1); } \
        __builtin_amdgcn_sched_barrier(0); \
          \
        f32x16 b0, b1; \
        _Pragma("unroll") for (int r = 0; r < 16; ++r) { \
            { float be = __builtin_amdgcn_rcpf(1.0f + __builtin_amdgcn_exp2f(-p0[r])), om = 1.0f - be; \
              if ((DIAG) && 16 * hi + r >= qloc) { be = 0.f; om = 1.f; } p0[r] = be; b0[r] = om; } \
            { float be = __builtin_amdgcn_rcpf(1.0f + __builtin_amdgcn_exp2f(-p1[r])), om = 1.0f - be; \
              if ((DIAG) && 32 + 16 * hi + r >= qloc) { be = 0.f; om = 1.f; } p1[r] = be; b1[r] = om; } } \
          \
        float t1_ = b1[15], t0_ = b0[15]; \
        _Pragma("unroll") for (int r = 14; r >= 0; --r) { p1[r] *= t1_; t1_ *= b1[r]; p0[r] *= t0_; t0_ *= b0[r]; } \
          \
        float o1_, o0_;                                       \
        { auto rr = __builtin_amdgcn_permlane32_swap(__float_as_uint(t1_), __float_as_uint(t1_), false, false); o1_ = __uint_as_float(rr[0] ^ rr[1] ^ __float_as_uint(t1_)); }     \
        { auto rr = __builtin_amdgcn_permlane32_swap(__float_as_uint(t0_), __float_as_uint(t0_), false, false); o0_ = __uint_as_float(rr[0] ^ rr[1] ^ __float_as_uint(t0_)); } \
        const float cu_ = carry * o1_, R1_ = hi ? carry : cu_;     \
        const float cP1_ = cu_ * t1_;                            \
        const float cv_ = cP1_ * o0_, R0_ = hi ? cP1_ : cv_;       \
        carry = cv_ * t0_; \
        _Pragma("unroll") for (int r = 0; r < 16; ++r) { p1[r] *= R1_; p0[r] *= R0_; } \
        if (MK_PROBE_SBVALU) { float x0_ = carry, x1_ = carry, x2_ = carry, x3_ = carry; _Pragma("unroll") for (int i_ = 0; i_ < 16; ++i_) asm volatile("v_add_f32 %0, %0, %0\n\tv_add_f32 %1, %1, %1\n\tv_add_f32 %2, %2, %2\n\tv_add_f32 %3, %3, %3" : "+v"(x0_), "+v"(x1_), "+v"(x2_), "+v"(x3_)); } \
        const u32x4 pw0 = PACK4(p0, 0), pw1 = PACK4(p0, 8), pw2 = PACK4(p1, 0), pw3 = PACK4(p1, 8); \
        __builtin_amdgcn_sched_barrier(0); \
        _Pragma("unroll") for (int d0 = 0; d0 < 2; ++d0) { \
            _Pragma("unroll") for (int ks = 0; ks < 4; ++ks) { const s16x4 lo = vtr(vp + vb_ + d0 * 4096 + (ks >> 1) * 2048 + (ks & 1) * 512), hh = vtr(vp + vb_ + d0 * 4096 + (ks >> 1) * 2048 + (ks & 1) * 512 + 256); \
                const bf16x8 vf = (bf16x8){lo[0], lo[1], lo[2], lo[3], hh[0], hh[1], hh[2], hh[3]}; \
                const u32x4 pk = ks == 0 ? pw0 : ks == 1 ? pw1 : ks == 2 ? pw2 : pw3; \
                o[d0] = MFMA32(__builtin_bit_cast(bf16x8, pk), vf, o[d0]); } \
            __builtin_amdgcn_sched_barrier(0); } \
    } while (0)
#define SB_DONE(t) ((t) == 0 || __all(carry < 1.0e-41f))
    { int t = tq;
      SB_TILE(kfA, kfB, true, t);
      if (!SB_DONE(t)) { --t;
          for (;;) { SB_TILE(kfB, kfA, false, t); if (SB_DONE(t)) break; --t;
                     SB_TILE(kfA, kfB, false, t); if (SB_DONE(t)) break; --t; } } }
#undef SB_DONE
#undef SB_TILE
#undef SB_DMA_V
#undef SB_LD_K
    asm volatile("s_waitcnt vmcnt(0)" ::: "memory");
    asm volatile("s_waitcnt lgkmcnt(0)" ::: "memory");
    int r32e = r32, hie = hi, lanee = lane; asm volatile("" : "+v"(r32e), "+v"(hie), "+v"(lanee));
    { lds_ptr stg = shm;
      const int c8 = lanee & 7, rsel = lanee >> 3;
      const f32x4v wv0 = *(const f32x4v*)(onw + 8 * c8), wv1 = *(const f32x4v*)(onw + 8 * c8 + 4);
#pragma unroll
      for (int r = 0; r < 16; ++r) { const int q = crow(r, hie);
#pragma unroll
          for (int d = 0; d < 2; ++d) *(__attribute__((address_space(3))) float*)(stg + q * 256 + (((8 * d + (r32e >> 2)) ^ (q & 15)) << 4) + (r32e & 3) * 4) = o[d][r]; }
      asm volatile("s_waitcnt lgkmcnt(0)" ::: "memory");
      float ss = 0.f;
#pragma unroll
      for (int k = 0; k < 8; ++k) { const f32x4v v = *(const __attribute__((address_space(3))) f32x4v*)(stg + r32e * 256 + (((8 * hie + k) ^ (r32e & 15)) << 4)); ss += (v[0] * v[0] + v[1] * v[1]) + (v[2] * v[2] + v[3] * v[3]); }
      ss = halves_sum(ss);
      if (hie == 0) wsf[r32e] = __builtin_amdgcn_rsqf(ss * (1.0f / 64.0f) + EPS);
      asm volatile("s_waitcnt lgkmcnt(0)" ::: "memory");
      bf16* op = MIX + (rowbase + q0w) * MP + 512 + h * 64 + 8 * c8;
#pragma unroll
      for (int i = 0; i < 4; ++i) { const int q = 8 * i + rsel; const float rs = wsf[q];
          const f32x4v v0 = *(const __attribute__((address_space(3))) f32x4v*)(stg + q * 256 + (((2 * c8) ^ (q & 15)) << 4));
          const f32x4v v1 = *(const __attribute__((address_space(3))) f32x4v*)(stg + q * 256 + (((2 * c8 + 1) ^ (q & 15)) << 4));
          u32x4 w; w.x = cvtpk(v0[0] * rs * wv0[0], v0[1] * rs * wv0[1]); w.y = cvtpk(v0[2] * rs * wv0[2], v0[3] * rs * wv0[3]);
          w.z = cvtpk(v1[0] * rs * wv1[0], v1[1] * rs * wv1[1]); w.w = cvtpk(v1[2] * rs * wv1[2], v1[3] * rs * wv1[3]);
          *(u32x4*)(op + (long)q * MP) = w; }
      asm volatile("s_waitcnt lgkmcnt(0)" ::: "memory");
    }
}
#undef MFMA32
#undef PACK4
}
struct Frame {
    LAS unsigned char* lds;
    volatile LAS unsigned* MISC;
    gu32* ctl;
    int tid, lane, wave;
    int vcu, G;
};
__device__ __forceinline__ float wave_max(float v) {
    v = fmaxf(v, __builtin_bit_cast(float, __builtin_amdgcn_update_dpp(0, __builtin_bit_cast(int, v), 0x128, 0xf, 0xf, false)));
    v = fmaxf(v, __builtin_bit_cast(float, __builtin_amdgcn_update_dpp(0, __builtin_bit_cast(int, v), 0x124, 0xf, 0xf, false)));
    v = fmaxf(v, __builtin_bit_cast(float, __builtin_amdgcn_update_dpp(0, __builtin_bit_cast(int, v), 0x122, 0xf, 0xf, false)));
    v = fmaxf(v, __builtin_bit_cast(float, __builtin_amdgcn_update_dpp(0, __builtin_bit_cast(int, v), 0x121, 0xf, 0xf, false)));
    { auto a = __builtin_amdgcn_permlane16_swap(__float_as_uint(v), __float_as_uint(v), false, false); v = fmaxf(__uint_as_float(a[0]), __uint_as_float(a[1])); }
    { auto a = __builtin_amdgcn_permlane32_swap(__float_as_uint(v), __float_as_uint(v), false, false); v = fmaxf(__uint_as_float(a[0]), __uint_as_float(a[1])); }
    return v;
}
__device__ __forceinline__ float wave_sum(float v) {
    v += __builtin_bit_cast(float, __builtin_amdgcn_update_dpp(0, __builtin_bit_cast(int, v), 0x128, 0xf, 0xf, false));
    v += __builtin_bit_cast(float, __builtin_amdgcn_update_dpp(0, __builtin_bit_cast(int, v), 0x124, 0xf, 0xf, false));
    v += __builtin_bit_cast(float, __builtin_amdgcn_update_dpp(0, __builtin_bit_cast(int, v), 0x122, 0xf, 0xf, false));
    v += __builtin_bit_cast(float, __builtin_amdgcn_update_dpp(0, __builtin_bit_cast(int, v), 0x121, 0xf, 0xf, false));
    { auto a = __builtin_amdgcn_permlane16_swap(__float_as_uint(v), __float_as_uint(v), false, false); v = __uint_as_float(a[0]) + __uint_as_float(a[1]); }
    { auto a = __builtin_amdgcn_permlane32_swap(__float_as_uint(v), __float_as_uint(v), false, false); v = __uint_as_float(a[0]) + __uint_as_float(a[1]); }
    return v;
}
__device__ __forceinline__ void p0_transpose_item(const float* W, int K, int N, bf16* WT, int k0, int n0, int prow0, const float* ks, LAS float* scr, int lane) {
    f32x4 tv[8]; float sc[8];
#pragma unroll
    for (int i = 0; i < 8; ++i) { const int kk = 8 * i + (lane >> 3); tv[i] = *(const GAS f32x4*)(W + (size_t)(k0 + kk) * N + n0 + 4 * (lane & 7)); sc[i] = ks ? ks[k0 + kk] : 1.0f; }
#pragma unroll
    for (int i = 0; i < 8; ++i) { const int kk = 8 * i + (lane >> 3); f32x4 v = tv[i]; if (ks) v = v * sc[i]; LAS float* d = scr + kk * 33 + 4 * (lane & 7); d[0] = v.x; d[1] = v.y; d[2] = v.z; d[3] = v.w; }
    LDS_WAIT(); asm volatile("" ::: "memory");
    const int c = lane & 7;
#pragma unroll
    for (int j = 0; j < 4; ++j) { const int n = (lane >> 3) + 8 * j; const LAS float* s = scr + (8 * c) * 33 + n;
        v4u o; o.x = pk2(s[0 * 33], s[1 * 33]); o.y = pk2(s[2 * 33], s[3 * 33]); o.z = pk2(s[4 * 33], s[5 * 33]); o.w = pk2(s[6 * 33], s[7 * 33]);
        *(GAS v4u*)(WT + (size_t)(prow0 + n) * K + k0 + 8 * c) = o; }
    LDS_WAIT(); asm volatile("" ::: "memory");
}
template <int NR> __device__ __forceinline__ void rms_rows_load(f32x4 (&v)[NR][4], int lane, const float* xrow) {
#pragma unroll
    for (int r = 0; r < NR; ++r) { const GAS f32x4* xr = (const GAS f32x4*)(xrow + (size_t)r * DMODEL) + lane;
#pragma unroll
        for (int j = 0; j < 4; ++j) v[r][j] = __builtin_nontemporal_load(xr + 64 * j); }
}
template <int NR> __device__ __forceinline__ void rms_rows_finish(const f32x4 (&v)[NR][4], int lane, bf16* orow, float* rinv, int row0) {
#pragma unroll
    for (int r = 0; r < NR; ++r) { float s = 0.f;
#pragma unroll
        for (int j = 0; j < 4; ++j) s += (v[r][j].x * v[r][j].x + v[r][j].y * v[r][j].y) + (v[r][j].z * v[r][j].z + v[r][j].w * v[r][j].w);
        const float ri = sqrtf(wave_sum(s) * (1.f / DMODEL) + EPS), rstd = 1.f / ri;
        if (lane == 0) rinv[pg8::rinv_index(row0 + r)] = ri;
        GAS unsigned long long* o8 = (GAS unsigned long long*)(orow + (size_t)r * DMODEL) + lane;
#pragma unroll
        for (int j = 0; j < 4; ++j) o8[64 * j] = (unsigned long long)pk2(v[r][j].x * rstd, v[r][j].y * rstd) | ((unsigned long long)pk2(v[r][j].z * rstd, v[r][j].w * rstd) << 32); }
}

struct Args { const float* in[17]; float* out; unsigned char* ws; int ph_lo, ph_hi, li, flags; };

__device__ __forceinline__ void p0_prologue(Frame& F, const Args& args, int part) {
    LAS float* scr = (LAS float*)(F.lds + RING_OFF + F.wave * 16384);
    const int gw = F.vcu * NWAVES + F.wave, NGW = F.G * NWAVES;
    unsigned char* ws = args.ws;
    bf16* Win_t = (bf16*)(ws + WS_WIN); bf16* Wout_t = (bf16*)(ws + WS_WOUT); bf16* Wgu_t = (bf16*)(ws + WS_WGU); bf16* Wd_t = (bf16*)(ws + WS_WD);
    constexpr int I_IN = (DMODEL / 64) * (INC / 32), I_OUT = (DMODEL / 64) * (DMODEL / 32), I_G = (DMODEL / 64) * (DFF / 32), I_D = (DFF / 64) * (DMODEL / 32);
    constexpr int NITEMS = I_IN + I_OUT + 2 * I_G + I_D;
    bf16* XN = (bf16*)(ws + WS_XN);
    for (int pass = 0; pass < 2; ++pass) {
    if ((pass == 0) == ((gw & 1) == 0)) {
    for (int it = part ? I_IN + gw : (F.wave < 6 ? F.vcu * 6 + F.wave : I_IN), dj = 0; ; it += F.G * 6) {
            if (part) {
                unsigned j = 0u; if (F.lane == 0) j = __hip_atomic_fetch_add((LAS unsigned*)(F.MISC + 17), 1u, __ATOMIC_RELAXED, __HIP_MEMORY_SCOPE_WORKGROUP);
                j = (unsigned)__builtin_amdgcn_readfirstlane((int)j); it = I_IN + F.vcu * NWAVES + (int)(j & 7u) + (int)(j >> 3) * NGW; (void)dj; }
            if (it >= (part ? NITEMS : I_IN)) break;
            int r = it;
            if (r < I_IN) { const int nblk = INC / 32, kb = r / nblk, nb = r % nblk, n0 = 32 * nb; const int L0 = n0 & 255, wc = L0 >> 6, bj = (L0 >> 5) & 1;
                p0_transpose_item(args.in[2], DMODEL, INC, Win_t, 64 * kb, n0, (n0 & ~255) + 128 * bj + 32 * wc, args.in[1], scr, F.lane); continue; } r -= I_IN;
            if (r < I_OUT) { const int nblk = DMODEL / 32, kb = r / nblk, nb = r % nblk; p0_transpose_item(args.in[11], DMODEL, DMODEL, Wout_t, 64 * kb, 32 * nb, 32 * nb, nullptr, scr, F.lane); continue; } r -= I_OUT;
            if (r < 2 * I_G) { const int up = r >= I_G; if (up) r -= I_G; const int nblk = DFF / 32, kb = r / nblk, nb = r % nblk, n0 = 32 * nb;
                p0_transpose_item(args.in[up ? 14 : 13], DMODEL, DFF, Wgu_t, 64 * kb, n0, 256 * (n0 >> 7) + 128 * up + (n0 & 127), args.in[12], scr, F.lane); continue; } r -= 2 * I_G;
            { const int nblk = DMODEL / 32, kb = r / nblk, nb = r % nblk; p0_transpose_item(args.in[15], DFF, DMODEL, Wd_t, 64 * kb, 32 * nb, 32 * nb, nullptr, scr, F.lane); }
        }
    } else {
        if (part == 0) {
            float* rinv = (float*)(ws + WS_RINV); const float* x = args.in[0]; const int st = 4 * NGW;
            for (int m = 4 * gw; m < MTOK; m += 2 * st) { f32x4 va[4][4], vb[4][4]; const int m2 = m + st; const bool h2 = m2 < MTOK;
                rms_rows_load<4>(va, F.lane, x + (size_t)m * DMODEL); if (h2) rms_rows_load<4>(vb, F.lane, x + (size_t)m2 * DMODEL);
                rms_rows_finish<4>(va, F.lane, XN + (size_t)m * DMODEL, rinv, m);
                if (h2) rms_rows_finish<4>(vb, F.lane, XN + (size_t)m2 * DMODEL, rinv, m2); } }
    }
    }
}

__global__ void __launch_bounds__(NWAVES * 64, 2) skel_fwd(Args args) {
    extern __shared__ __attribute__((aligned(16))) unsigned char lds[];
    Frame F;
    F.lds = (LAS unsigned char*)lds;
    F.MISC = (volatile LAS unsigned*)(F.lds + MISC_OFF);
    F.tid = threadIdx.x; F.lane = F.tid & 63; F.wave = __builtin_amdgcn_readfirstlane(F.tid >> 6);
    F.G = gridDim.x; { const int bx = blockIdx.x; F.vcu = (F.G % 8 == 0) ? (bx % 8) * (F.G / 8) + bx / 8 : bx; }
    unsigned char* ws = args.ws;
    F.ctl = (gu32*)(ws + WS_CTL);
    for (int u = F.tid; u < (LDS_BYTES - LDSCTL_OFF) / 4; u += NWAVES * 64) ((LAS unsigned*)(F.lds + LDSCTL_OFF))[u] = 0u;
    __syncthreads();
    XcdBarrier bar = xcd_barrier_post((unsigned*)(F.ctl + CW_BAR) + args.li * XB_WORDS_ALL, F.MISC + 8);
    if (F.tid == 0) xcd_local_setup(bar);
    const int lo = args.ph_lo, hi = args.ph_hi;
#define IN(k) (lo <= (k) && (k) < hi)
#define BOTH(k) (IN(k) && IN((k) + 1))
    bf16* Win_t = (bf16*)(ws + WS_WIN); bf16* Wout_t = (bf16*)(ws + WS_WOUT); bf16* Wgu_t = (bf16*)(ws + WS_WGU); bf16* Wd_t = (bf16*)(ws + WS_WD);
    bf16* PROJ = (bf16*)(ws + WS_PROJ); bf16* XN = (bf16*)(ws + WS_XN); bf16* MIX = (bf16*)(ws + WS_MIX); bf16* XH = (bf16*)(ws + WS_XH); bf16* ACT = (bf16*)(ws + WS_ACT); float* SSQ = (float*)(ws + WS_SSQ);

    if (IN(0)) { for (int rep = 0; rep < MK_REP_P0; ++rep) p0_prologue(F, args, 0); if (BOTH(0)) { xcd_barrier(bar); if (MK_PROBE_XBAR2) xcd_barrier(bar); } }
    if (MK_LOCAL_SEAMS && BOTH(0)) { if (F.tid == 0) F.MISC[18] = xcd_local_ok(bar) ? 1u : 0u; __syncthreads(); }
    const bool lseam = MK_LOCAL_SEAMS && BOTH(0) && F.MISC[18] != 0u;
    if (IN(1)) {
        pg8::Gemm g{XN, Win_t, MTOK, INC, DMODEL}; pg8::StaticOrder S; S.init(MTOK, INC, F.G, (int)blockIdx.x, MK_REP_P1);
        pg8::EpiInProj E{PROJ, args.in[3], args.in[4]};
        pg8::gemm_phase<pg8::EpiInProj, pg8::StaticOrder, PG8_ALIGN, PG8_SP2>(F.lds + RING_OFF, g, S, E);
        if (BOTH(1)) { if (lseam && F.G == 256) xcd_local_barrier(bar); else xcd_barrier(bar); if (MK_PROBE_XBAR2) xcd_barrier(bar); }
    }
    if (IN(2)) {
        const bf16* DQ = PROJ; const size_t TS = (size_t)MTOK * 512;
        att::lds_ptr ring = (att::lds_ptr)(F.lds + RING_OFF); att::lds_ptr wsfb = (att::lds_ptr)(F.lds + WSF_OFF);
        LAS float* tab = (LAS float*)(F.lds + TAB_OFF);
        for (int i = F.tid; i < 1024; i += NWAVES * 64) { const int h = i >> 8, rel = (i & 255) - 191; tab[i] = (i & 255) == 255 ? args.in[16][15 * 4 + h] * att::LOG2E : (args.in[16][att::t5_bucket(rel) * 4 + h] - args.in[16][15 * 4 + h]) * att::LOG2E; }
        const float lam = __expf(wave_sum(args.in[5][F.lane] * args.in[6][F.lane])) - __expf(wave_sum(args.in[7][F.lane] * args.in[8][F.lane])) + 0.2f;
        const float sbound = 1.02f * 64.0f * pg8::C2_ * wave_max(fabsf(args.in[3][F.lane])) * wave_max(fabsf(args.in[4][F.lane]));
        { const f32x4 rb4 = *(const f32x4*)(args.in[16] + (F.lane & 31) * 4);
          const float m0 = wave_max(rb4.x), m1 = wave_max(rb4.y), m2 = wave_max(rb4.z), m3 = wave_max(rb4.w);
          if (F.tid == 0) { F.MISC[20] = __float_as_uint(sbound + att::LOG2E * m0); F.MISC[21] = __float_as_uint(sbound + att::LOG2E * m1); F.MISC[22] = __float_as_uint(sbound + att::LOG2E * m2); F.MISC[23] = __float_as_uint(sbound + att::LOG2E * m3); } }
        __syncthreads();
        for (int rep = 0; rep < MK_REP_DIFF; ++rep)
        if (args.flags & 1) { att::bf16x8 qfr[4];
            const int nun = 2 * ((512 - F.vcu + F.G - 1) / F.G);
#define DPAIR(j) (F.G == 256 ? 64 * (F.vcu >> 5) + (F.vcu & 31) + 32 * (j) : F.vcu + (j) * F.G)
            for (int k = 0; k < nun; ++k) { const int pr = DPAIR(k >> 1), bh = pr >> 4, s = pr & 15, h = bh & 3, u = (k & 1) ? s : 31 - s;
                const int k2 = k + 1, pr2 = DPAIR(k2 >> 1), bh2 = pr2 >> 4, s2 = pr2 & 15, u2 = (k2 & 1) ? s2 : 31 - s2;
                const float mbound = __uint_as_float(F.MISC[20 + h]);
                att::diff_unit<6>(bh >> 2, h, u, DQ, DQ + TS, DQ + 2 * TS, MIX, (att::lds_cptr)(tab + h * 256), tab[h * 256 + 255], mbound, lam, args.in[9], ring, wsfb, qfr, k > 0, bh2 >> 2, bh2 & 3, k2 < nun ? u2 : -1); } }
        for (int rep = 0; rep < MK_REP_SB; ++rep)
        if (args.flags & 2) for (int grp = F.vcu; grp < 256; grp += F.G) {
            if (F.tid == 0) F.MISC[16] = 0u;
            __syncthreads();
            for (;;) { unsigned qi = 0u; if (F.lane == 0) qi = __hip_atomic_fetch_add((LAS unsigned*)(F.MISC + 16), 1u, __ATOMIC_RELAXED, __HIP_MEMORY_SCOPE_WORKGROUP);
                qi = (unsigned)__builtin_amdgcn_readfirstlane((int)qi); if (qi >= 32u) break;
                const int item = grp * 32 + (int)qi, bh = item >> 7, rb = item & 127;
                att::sb_item(bh >> 3, bh & 7, rb, DQ + 3 * TS, DQ + 4 * TS, DQ + 5 * TS, MIX, args.in[10], ring + F.wave * 16384, wsfb + F.wave * 512); }
            if (grp + F.G < 256) __syncthreads(); }
        p0_prologue(F, args, 1);
        if (BOTH(2)) { xcd_barrier(bar); if (MK_PROBE_XBAR2) xcd_barrier(bar); }
    }
    if (IN(3)) {
        pg8::Gemm g{MIX, Wout_t, MTOK, DMODEL, DMODEL}; pg8::StaticOrder S; S.init(MTOK, DMODEL, F.G, (int)blockIdx.x, MK_REP_P3);
        pg8::EpiOutProj E{XN, (const float*)(ws + WS_RINV), XH, SSQ};
        pg8::gemm_phase<pg8::EpiOutProj, pg8::StaticOrder, PG8_ALIGN, PG8_SP2>(F.lds + RING_OFF, g, S, E);
        if (BOTH(3)) { if (lseam) xcd_local_barrier(bar); else xcd_barrier(bar); if (MK_PROBE_XBAR2) xcd_barrier(bar); }
    }
    if (IN(4)) {
        pg8::Gemm g{XH, Wgu_t, MTOK, NGU, DMODEL}; pg8::StaticOrder S; S.init(MTOK, NGU, F.G, (int)blockIdx.x, MK_REP_P4);
        int pml[4] = {-1, -1, -1, -1};
        { pg8::Unit uu; int n = 0; for (int i = 0; S.next(i, uu) && uu.rep == 0; ++i) { if (uu.pm != pml[0] && uu.pm != pml[1] && uu.pm != pml[2] && uu.pm != pml[3] && n < 4) { if (n == 0) pml[0] = uu.pm; else if (n == 1) pml[1] = uu.pm; else if (n == 2) pml[2] = uu.pm; else pml[3] = uu.pm; ++n; } } }
        LAS float* rsl = (LAS float*)(F.lds + RSTD_OFF);
        pg8::EpiSwiGLU E{SSQ, ACT, (const LAS float*)rsl, pml[0], pml[1], pml[2], pml[3]};
        pg8::gemm_phase<pg8::EpiSwiGLU, pg8::StaticOrder, PG8_ALIGN, PG8_SP2>(F.lds + RING_OFF, g, S, E);
        if (BOTH(4)) { if (lseam) xcd_local_barrier(bar); else xcd_barrier(bar); if (MK_PROBE_XBAR2) xcd_barrier(bar); }
    }
    if (IN(5)) {
        pg8::Gemm g{ACT, Wd_t, MTOK, DMODEL, DFF}; pg8::StaticOrder S; S.init(MTOK, DMODEL, F.G, (int)blockIdx.x, MK_REP_P5, MK_WGM_P5);
        int pml[4] = {-1, -1, -1, -1};
        { pg8::Unit uu; int n = 0; for (int i = 0; S.next(i, uu) && uu.rep == 0; ++i) { if (uu.pm != pml[0] && uu.pm != pml[1] && uu.pm != pml[2] && uu.pm != pml[3] && n < 4) { if (n == 0) pml[0] = uu.pm; else if (n == 1) pml[1] = uu.pm; else if (n == 2) pml[2] = uu.pm; else pml[3] = uu.pm; ++n; } } }
        LAS float* rsl = (LAS float*)(F.lds + RSTD_OFF);
        pg8::EpiDown E{XH, args.out, SSQ, (const LAS float*)rsl, pml[0], pml[1], pml[2], pml[3]};
        pg8::gemm_phase<pg8::EpiDown, pg8::StaticOrder, PG8_ALIGN, PG8_SP2>(F.lds + RING_OFF, g, S, E);
    }
#undef IN
#undef BOTH
}
extern "C" void kernel_launch(void* const* d_in, const int* in_sizes, int n_in, void* d_out, int out_size, void* d_ws, size_t ws_size, hipStream_t stream) {
    static int grid = 0;
    if (grid == 0) {
        if (n_in != 17 || in_sizes[0] != MTOK * DMODEL || out_size != MTOK * DMODEL || ws_size < WS_END) { fprintf(stderr, "kernel_launch: unexpected problem shape; nothing launched\n"); grid = -1; return; }
        int dev = 0, cus = 0, per_cu = 0;
        if (hipGetDevice(&dev) != hipSuccess || hipDeviceGetAttribute(&cus, hipDeviceAttributeMultiprocessorCount, dev) != hipSuccess) { grid = -1; return; }
        if (hipFuncSetAttribute((const void*)skel_fwd, hipFuncAttributeMaxDynamicSharedMemorySize, LDS_BYTES) != hipSuccess) { fprintf(stderr, "kernel_launch: hipFuncSetAttribute failed\n"); grid = -1; return; }
        if (hipOccupancyMaxActiveBlocksPerMultiprocessor(&per_cu, (const void*)skel_fwd, NWAVES * 64, LDS_BYTES) != hipSuccess || per_cu < 1) { fprintf(stderr, "kernel_launch: occupancy query reports %d\n", per_cu); per_cu = 1; }
        (void)hipGetLastError();
        grid = cus;
    }
    if (grid < 0) return;
    if (hipMemsetAsync((char*)d_ws + WS_CTL, 0, CTL_ZERO_BYTES, stream) != hipSuccess) return;
    Args a{};
    for (int i = 0; i < 17; ++i) a.in[i] = (const float*)d_in[i];
    a.out = (float*)d_out; a.ws = (unsigned char*)d_ws;
    a.ph_lo = 0; a.ph_hi = 6; a.li = 0; a.flags = 3;
    hipLaunchKernelGGL(skel_fwd, dim3(grid), dim3(NWAVES * 64), LDS_BYTES, stream, a);
}
```
